# Optimizing an MI355X kernel written in HIP

```python
import jax, jax.numpy as jnp
from jax import lax
import numpy as np

D_MODEL = 2048
BATCH = 4
SEQ = 2048
DEPTH = 2
DEC_BATCH = 16
DEC_SEQ = 64
PAST_LEN = 4096

CHUNK = 64
N_HEADS = D_MODEL // 256
HEAD_DIM = 128
D_ATTN = N_HEADS * HEAD_DIM
D_CONV = D_MODEL // 2
CONV_WIDTH = 31
Q_BLOCK = 128
EPS = 1e-6
D_IN = 4 * D_ATTN + N_HEADS + 3 * D_CONV + 2 * D_MODEL

kernel_name = "fox_conformer_gated_hybrid_stream_step"


def _split_points():
    sizes = (D_ATTN, D_ATTN, D_ATTN, N_HEADS, D_ATTN, 2 * D_CONV, D_CONV, D_MODEL, D_MODEL)
    return np.cumsum(np.array(sizes))[:-1].tolist()


def _rmsnorm(x, g):
    xf = x.astype(jnp.float32)
    y = xf * lax.rsqrt(jnp.mean(xf * xf, axis=-1, keepdims=True) + EPS) * g.astype(jnp.float32)
    return y.astype(x.dtype)


def _layernorm(x, g, b):
    xf = x.astype(jnp.float32)
    mu = jnp.mean(xf, axis=-1, keepdims=True)
    var = jnp.mean(jnp.square(xf - mu), axis=-1, keepdims=True)
    y = (xf - mu) * lax.rsqrt(var + EPS) * g.astype(jnp.float32) + b.astype(jnp.float32)
    return y.astype(x.dtype)


def _fox_prompt(q, k, v, logf):
    B, S, H, Dh = q.shape
    scale = Dh ** -0.5
    F = jnp.cumsum(logf, axis=1).transpose(0, 2, 1)
    nb = S // Q_BLOCK
    qb = q.reshape(B, nb, Q_BLOCK, H, Dh).transpose(1, 0, 2, 3, 4)
    Fb = F.reshape(B, H, nb, Q_BLOCK).transpose(2, 0, 1, 3)
    pos_k = jnp.arange(S)

    def one_block(args):
        i, qi, Fi = args
        s = jnp.einsum('bqhd,bkhd->bhqk', qi, k, preferred_element_type=jnp.float32) * scale
        bias = Fi[..., :, None] - F[..., None, :]
        pos_q = i * Q_BLOCK + jnp.arange(Q_BLOCK)
        mask = pos_k[None, :] <= pos_q[:, None]
        s = jnp.where(mask, s + bias, -jnp.inf)
        p = jax.nn.softmax(s, axis=-1)
        return jnp.einsum('bhqk,bkhd->bqhd', p.astype(v.dtype), v)

    out = lax.map(one_block, (jnp.arange(nb), qb, Fb))
    return out.transpose(1, 0, 2, 3, 4).reshape(B, S, H * Dh)


def _fox_sample(q, k_new, v_new, logf_new, k_cache, v_cache, logf_cache):
    B, T, H, Dh = q.shape
    P = k_cache.shape[1]
    scale = Dh ** -0.5
    k_all = jnp.concatenate([k_cache.astype(k_new.dtype), k_new], axis=1)
    v_all = jnp.concatenate([v_cache.astype(v_new.dtype), v_new], axis=1)
    logf_all = jnp.concatenate([logf_cache.astype(jnp.float32), logf_new], axis=1)
    F = jnp.cumsum(logf_all, axis=1).transpose(0, 2, 1)
    Fq = F[:, :, P:]
    s = jnp.einsum('bqhd,bkhd->bhqk', q, k_all, preferred_element_type=jnp.float32) * scale
    bias = Fq[..., :, None] - F[..., None, :]
    pos_k = jnp.arange(P + T)
    pos_q = P + jnp.arange(T)
    mask = pos_k[None, :] <= pos_q[:, None]
    s = jnp.where(mask, s + bias, -jnp.inf)
    p = jax.nn.softmax(s, axis=-1)
    out = jnp.einsum('bhqk,bkhd->bqhd', p.astype(v_all.dtype), v_all)
    return out.reshape(B, T, H * Dh)


def _depthwise_causal(u, buf, w, b):
    ext = jnp.concatenate([buf.astype(u.dtype), u], axis=1)
    y = lax.conv_general_dilated(ext, w[:, None, :].astype(u.dtype), window_strides=(1,), padding='VALID',
                                 dimension_numbers=('NWC', 'WIO', 'NWC'), feature_group_count=u.shape[-1])
    return y + b, ext[:, -(CONV_WIDTH - 1):]


def _layer(x, c, k_cache, v_cache, logf_cache, conv_buf,
           w_ada, b_ada, norm_g, w_in, b_f, q_g, k_g,
           conv_w, conv_b, ln_g, ln_b, w_oa, w_ob, w_out):
    B, T, _ = x.shape
    mod = jnp.einsum('bd,de->be', jax.nn.silu(c), w_ada) + b_ada
    shift, scale, gate = jnp.split(mod, 3, axis=-1)
    h = _rmsnorm(x, norm_g) * (1 + scale[:, None]) + shift[:, None]
    z = jnp.einsum('btd,de->bte', h, w_in)
    q, k, v, f_logit, g_a, glu_in, g_b, m_a, m_b = jnp.split(z, _split_points(), axis=-1)
    q = _rmsnorm(q.reshape(B, T, N_HEADS, HEAD_DIM), q_g)
    k = _rmsnorm(k.reshape(B, T, N_HEADS, HEAD_DIM), k_g)
    v = v.reshape(B, T, N_HEADS, HEAD_DIM)
    logf = jax.nn.log_sigmoid((f_logit + b_f).astype(jnp.float32))

    if k_cache is None:
        attn = _fox_prompt(q, k, v, logf)
        buf0 = jnp.zeros((B, CONV_WIDTH - 1, D_CONV), x.dtype)
    else:
        attn = _fox_sample(q, k, v, logf, k_cache, v_cache, logf_cache)
        buf0 = conv_buf
    y_a = attn * jax.nn.silu(g_a)

    ga_lin, ga_gate = jnp.split(glu_in, 2, axis=-1)
    u = ga_lin * jax.nn.sigmoid(ga_gate)
    cv, new_buf = _depthwise_causal(u, buf0, conv_w, conv_b)
    cv = jax.nn.silu(_layernorm(cv, ln_g, ln_b))
    y_b = cv * jax.nn.silu(g_b)

    p_a = jnp.einsum('btc,cd->btd', y_a, w_oa)
    p_b = jnp.einsum('btc,cd->btd', y_b, w_ob)
    merged = jax.nn.sigmoid(m_a) * p_a + jax.nn.sigmoid(m_b) * p_b
    out = jnp.einsum('btd,de->bte', merged, w_out)
    x = x + gate[:, None] * out
    return x, k, v, logf, new_buf


def setup_inputs(seed: int = 0) -> dict:
    key = jax.random.key(seed)
    ks = jax.random.split(key, 24)
    n = jax.random.normal
    D = D_MODEL
    return {
        "x_prompt": n(ks[0], (BATCH, SEQ, D), jnp.float32),
        "x_sample": n(ks[1], (DEC_BATCH, DEC_SEQ, D), jnp.float32),
        "c_prompt": n(ks[2], (BATCH, D), jnp.float32),
        "c_sample": n(ks[3], (DEC_BATCH, D), jnp.float32),
        "cache_k": n(ks[4], (DEPTH, DEC_BATCH, PAST_LEN, N_HEADS, HEAD_DIM), jnp.float32),
        "cache_v": n(ks[5], (DEPTH, DEC_BATCH, PAST_LEN, N_HEADS, HEAD_DIM), jnp.float32),
        "cache_logf": jax.nn.log_sigmoid(3.0 + 0.5 * n(ks[6], (DEPTH, DEC_BATCH, PAST_LEN, N_HEADS), jnp.float32)),
        "state_conv": 0.5 * n(ks[7], (DEPTH, DEC_BATCH, CONV_WIDTH - 1, D_CONV), jnp.float32),
        "w_ada": 0.3 * D ** -0.5 * n(ks[8], (DEPTH, D, 3 * D), jnp.float32),
        "b_ada": 0.02 * n(ks[9], (DEPTH, 3 * D), jnp.float32),
        "norm_g": 1.0 + 0.05 * n(ks[10], (DEPTH, D), jnp.float32),
        "w_in": D ** -0.5 * n(ks[11], (DEPTH, D, D_IN), jnp.float32),
        "b_f": 3.0 + 0.5 * n(ks[12], (DEPTH, N_HEADS), jnp.float32),
        "q_norm_g": 1.0 + 0.05 * n(ks[13], (DEPTH, HEAD_DIM), jnp.float32),
        "k_norm_g": 1.0 + 0.05 * n(ks[14], (DEPTH, HEAD_DIM), jnp.float32),
        "conv_w": CONV_WIDTH ** -0.5 * n(ks[15], (DEPTH, CONV_WIDTH, D_CONV), jnp.float32),
        "conv_b": 0.02 * n(ks[16], (DEPTH, D_CONV), jnp.float32),
        "conv_ln_g": 1.0 + 0.05 * n(ks[17], (DEPTH, D_CONV), jnp.float32),
        "conv_ln_b": 0.02 * n(ks[18], (DEPTH, D_CONV), jnp.float32),
        "w_oa": D_ATTN ** -0.5 * n(ks[19], (DEPTH, D_ATTN, D), jnp.float32),
        "w_ob": D_CONV ** -0.5 * n(ks[20], (DEPTH, D_CONV, D), jnp.float32),
        "w_out": D ** -0.5 * n(ks[21], (DEPTH, D, D), jnp.float32),
    }


def reference(x_prompt, x_sample, c_prompt, c_sample, cache_k, cache_v, cache_logf, state_conv,
              w_ada, b_ada, norm_g, w_in, b_f, q_norm_g, k_norm_g, conv_w, conv_b,
              conv_ln_g, conv_ln_b, w_oa, w_ob, w_out):
    xp, xs = x_prompt, x_sample
    kp, vp, fp, cp = [], [], [], []
    ksm, vsm, fsm, csm = [], [], [], []
    for l in range(DEPTH):
        wl = (w_ada[l], b_ada[l], norm_g[l], w_in[l], b_f[l], q_norm_g[l], k_norm_g[l],
              conv_w[l], conv_b[l], conv_ln_g[l], conv_ln_b[l], w_oa[l], w_ob[l], w_out[l])
        xp, k1, v1, f1, b1 = _layer(xp, c_prompt, None, None, None, None, *wl)
        xs, k2, v2, f2, b2 = _layer(xs, c_sample, cache_k[l], cache_v[l], cache_logf[l], state_conv[l], *wl)
        kp.append(k1); vp.append(v1); fp.append(f1); cp.append(b1)
        ksm.append(k2); vsm.append(v2); fsm.append(f2); csm.append(b2)
    return (xp, xs,
            jnp.stack(kp), jnp.stack(vp), jnp.stack(fp), jnp.stack(cp),
            jnp.stack(ksm), jnp.stack(vsm), jnp.stack(fsm), jnp.stack(csm))
```

```cpp
#include <hip/hip_runtime.h>
#include <cstdio>
#include <cstdint>
#ifndef MK_ONE_LAUNCH
#define MK_ONE_LAUNCH 1
#endif
__device__ __forceinline__ int opaque_tid() { int t = threadIdx.x; asm volatile("" : "+v"(t)); return t; }
namespace pg8 {
#define PG8_LAS __attribute__((address_space(3)))
typedef unsigned short bf16_t;
typedef short bf16x8 __attribute__((ext_vector_type(8)));
typedef float f32x4 __attribute__((ext_vector_type(4)));
typedef unsigned u32x4 __attribute__((ext_vector_type(4)));
constexpr int BM = 256, BK = 64, HALF = 128, HTB = HALF * BK * 2  , STAGE_BYTES = 8 * HTB, NXCD = 8, WGM = 8;

__host__ __device__ __forceinline__ int lds_byte(int r, int c) { const int st = (r >> 4) * 2 + (c >> 5), rr = r & 15, cc = c & 31, ob = rr * 64 + cc * 2; return st * 1024 + (ob ^ (((ob >> 9) & 1) << 5)); }
__host__ __device__ __forceinline__ void stage_rc(int b, int& R, int& C) { const int st = b / 1024, sb = b % 1024, swz = sb ^ (((sb >> 9) & 1) << 5); R = (st >> 1) * 16 + swz / 64; C = (st & 1) * 32 + (swz % 64) / 2; }
__host__ __device__ __forceinline__ int perm32(int rho) { const int n = rho >> 4, i = rho & 15; return 8 * (i >> 2) + 4 * n + (i & 3); }

struct Unit { int pm, pn; };
struct Gemm { const bf16_t* A; const bf16_t* Bt; int M, N, K; };

struct StaticOrder {
    int nM, nN, nwg, G, c;
    __host__ __device__ void init(int M, int N, int G_, int c_) { nM = M / BM; nN = N / BM; nwg = nM * nN; G = G_; c = c_; }
    __host__ __device__ bool next(int i, Unit& u) const {
        const long L = (long)i * G + c; if (L >= nwg) return false;
        int wgid = (int)L; { const int q = nwg / NXCD, r = nwg % NXCD, xcd = wgid % NXCD, off = wgid / NXCD; wgid = (xcd < r ? xcd * (q + 1) : r * (q + 1) + (xcd - r) * q) + off; }
        const int nig = WGM * nN, gid = wgid / nig, fm = gid * WGM, gsz = (nM - fm) < WGM ? (nM - fm) : WGM;
        u.pm = fm + ((wgid % nig) % gsz); u.pn = (wgid % nig) / gsz; return true;
    }
    __device__ __forceinline__ void a_ready(const Unit&) const {}
    __device__ __forceinline__ void done(const Unit&) const {}
};

__device__ __forceinline__ unsigned cvt_pk_bf16(float lo, float hi) { unsigned r; asm volatile("v_cvt_pk_bf16_f32 %0, %1, %2" : "=v"(r) : "v"(lo), "v"(hi)); return r; }
typedef float f32x2 __attribute__((ext_vector_type(2)));
template <class Epi, class Sched, bool ALIGN_EPI = false, bool SP2 = false>
__device__ __forceinline__ void gemm_phase(PG8_LAS unsigned char* lds, const Gemm g, const Sched& S, const Epi& E) {
    const int tid = opaque_tid(), wid = __builtin_amdgcn_readfirstlane(tid >> 6), lane = tid & 63, wr = wid >> 2, wc = wid & 3, fr = lane & 15, fq = lane >> 4;
    const int K = g.K, nt = K / BK;
    unsigned voffA[2], voffB[2];
#pragma unroll
    for (int i = 0; i < 2; ++i) { int R, C; stage_rc(tid * 16 + i * 8192, R, C); const int Rb = Epi::PERM ? ((R & ~31) + perm32(R & 31)) : R;
        voffA[i] = (unsigned)(R * K + C) * 2u; voffB[i] = (unsigned)(Rb * K + C) * 2u; }
    const size_t kstep = (size_t)(BK * 2);
    const size_t hstep = (size_t)HALF * K * 2;
    const size_t tstep = 2 * hstep;
    const unsigned ldsw = (unsigned)wid * 1024u;
    const int aoff = lds_byte(wr * 64 + fr, fq * 8), boff = lds_byte(wc * 32 + fr, fq * 8);
#define PG8_SA(b, h) (((b) * 2 + (h)) * HTB)
#define PG8_SB(b, h) ((4 + (b) * 2 + (h)) * HTB)
#define PG8_STAGE(bufoff, gbase, voff) do { _Pragma("unroll") for (int _i = 0; _i < 2; ++_i) \
        __builtin_amdgcn_global_load_lds((const unsigned*)((const char*)(gbase) + (voff)[_i]), (PG8_LAS unsigned*)(lds + (bufoff) + ldsw + _i * 8192), 16, 0, 0); } while (0)
#define PG8_LDA(dst, b, h) do { _Pragma("unroll") for (int m = 0; m < 4; ++m) _Pragma("unroll") for (int k = 0; k < 2; ++k) dst[m][k] = *(const PG8_LAS bf16x8*)(lds + PG8_SA(b, h) + aoff + m * 2048 + k * 1024); } while (0)
#define PG8_LDB(dst, b, h) do { _Pragma("unroll") for (int n = 0; n < 2; ++n) _Pragma("unroll") for (int k = 0; k < 2; ++k) dst[n][k] = *(const PG8_LAS bf16x8*)(lds + PG8_SB(b, h) + boff + n * 2048 + k * 1024); } while (0)
#define PG8_MMA(ai, bj, At, Bt) do { __builtin_amdgcn_s_setprio(1); _Pragma("unroll") for (int m = 0; m < 4; ++m) _Pragma("unroll") for (int n = 0; n < 2; ++n) _Pragma("unroll") for (int k = 0; k < 2; ++k) \
        acc[ai][bj][m][n] = __builtin_amdgcn_mfma_f32_16x16x32_bf16(Bt[n][k], At[m][k], acc[ai][bj][m][n], 0, 0, 0); __builtin_amdgcn_s_setprio(0); } while (0)
#define PG8_WAIT_V(n) asm volatile("s_waitcnt vmcnt(" #n ")" ::: "memory")
#define PG8_WAIT_L(n) asm volatile("s_waitcnt lgkmcnt(" #n ")" ::: "memory")
#define PG8_BAR __builtin_amdgcn_s_barrier()
#define PG8_SCHED __builtin_amdgcn_sched_barrier(0)
    Unit cur, nxt; int ui = 0;
    if (!S.next(0, cur)) return;
    f32x4 acc[2][2][4][2];
#pragma unroll
    for (int a = 0; a < 2; ++a)
#pragma unroll
        for (int b = 0; b < 2; ++b)
#pragma unroll
            for (int m = 0; m < 4; ++m)
#pragma unroll
                for (int n = 0; n < 2; ++n) acc[a][b][m][n] = (f32x4){0.f, 0.f, 0.f, 0.f};
    bf16x8 At[4][2], B0[2][2], B1[2][2];
    const char* cA = (const char*)g.A + (size_t)cur.pm * tstep; const char* cB = (const char*)g.Bt + (size_t)cur.pn * tstep;
    S.a_ready(cur);
    if constexpr (SP2) {
        PG8_STAGE(PG8_SB(0, 0), cB, voffB); PG8_STAGE(PG8_SB(0, 1), cB + hstep, voffB); PG8_STAGE(PG8_SA(0, 0), cA, voffA); PG8_STAGE(PG8_SA(0, 1), cA + hstep, voffA);
        if (wr == 1) PG8_BAR;
        PG8_WAIT_V(2); PG8_BAR;
        PG8_STAGE(PG8_SB(1, 0), cB + kstep, voffB); PG8_STAGE(PG8_SA(1, 0), cA + kstep, voffA); PG8_STAGE(PG8_SB(1, 1), cB + hstep + kstep, voffB);
        PG8_WAIT_V(6); PG8_BAR;
    } else {
        PG8_STAGE(PG8_SB(0, 0), cB, voffB); PG8_STAGE(PG8_SA(0, 0), cA, voffA); PG8_STAGE(PG8_SB(0, 1), cB + hstep, voffB); PG8_STAGE(PG8_SA(0, 1), cA + hstep, voffA);
        if (wr == 1) PG8_BAR;
        PG8_WAIT_V(4); PG8_BAR;
        PG8_STAGE(PG8_SB(1, 0), cB + kstep, voffB); PG8_STAGE(PG8_SA(1, 0), cA + kstep, voffA); PG8_STAGE(PG8_SB(1, 1), cB + hstep + kstep, voffB);
        PG8_WAIT_V(6); PG8_BAR;
    }
    for (;;) {
        const bool has_next = S.next(ui + 1, nxt);
        const char* nA = has_next ? (const char*)g.A + (size_t)nxt.pm * tstep : cA; const char* nB = has_next ? (const char*)g.Bt + (size_t)nxt.pn * tstep : cB;
        for (int t = 0; t < nt; t += 2) {
            if constexpr (Epi::HAS_MID) { if (t == (nt >> 1)) { E.mid(acc, cur, wr, wc, fr, fq); PG8_SCHED; } }
            const bool last = (t == nt - 2);
            const char* a1 = cA + (size_t)(t + 1) * kstep;
            const char* a2 = last ? nA : cA + (size_t)(t + 2) * kstep; const char* b2 = last ? nB : cB + (size_t)(t + 2) * kstep;
            const char* a3 = a2 + kstep; const char* b3 = b2 + kstep;
            if (last && has_next) S.a_ready(nxt);
            if constexpr (SP2) {
            PG8_LDB(B0, 0, 0); PG8_LDB(B1, 0, 1); PG8_SCHED; PG8_LDA(At, 0, 0); PG8_STAGE(PG8_SA(1, 1), a1 + hstep, voffA);
            PG8_WAIT_V(8); PG8_WAIT_L(0); PG8_BAR; PG8_MMA(0, 0, At, B0); PG8_MMA(0, 1, At, B1); PG8_BAR; PG8_SCHED;
            PG8_LDA(At, 0, 1); PG8_STAGE(PG8_SB(0, 0), b2, voffB); PG8_STAGE(PG8_SB(0, 1), b2 + hstep, voffB); PG8_STAGE(PG8_SA(0, 0), a2, voffA);
            PG8_WAIT_V(8); PG8_WAIT_L(0); PG8_BAR; PG8_MMA(1, 0, At, B0); PG8_MMA(1, 1, At, B1); PG8_BAR; PG8_SCHED;
            PG8_LDB(B0, 1, 0); PG8_LDB(B1, 1, 1); PG8_SCHED; PG8_LDA(At, 1, 0); PG8_STAGE(PG8_SA(0, 1), a2 + hstep, voffA);
            PG8_WAIT_V(8); PG8_WAIT_L(0); PG8_BAR; PG8_MMA(0, 0, At, B0); PG8_MMA(0, 1, At, B1); PG8_BAR; PG8_SCHED;
            PG8_LDA(At, 1, 1); PG8_STAGE(PG8_SB(1, 0), b3, voffB); PG8_STAGE(PG8_SB(1, 1), b3 + hstep, voffB); PG8_STAGE(PG8_SA(1, 0), a3, voffA);
            PG8_WAIT_V(8); PG8_WAIT_L(0); PG8_BAR; PG8_MMA(1, 0, At, B0); PG8_MMA(1, 1, At, B1); PG8_BAR; PG8_SCHED;
            } else {
            PG8_LDB(B0, 0, 0); PG8_SCHED; PG8_LDA(At, 0, 0); PG8_STAGE(PG8_SA(1, 1), a1 + hstep, voffA);
            PG8_WAIT_L(8); PG8_BAR; PG8_WAIT_L(0); PG8_MMA(0, 0, At, B0); PG8_BAR; PG8_SCHED;
            PG8_LDB(B1, 0, 1); PG8_STAGE(PG8_SB(0, 0), b2, voffB);
            PG8_BAR; PG8_WAIT_L(0); PG8_MMA(0, 1, At, B1); PG8_BAR;
            PG8_LDA(At, 0, 1); PG8_STAGE(PG8_SA(0, 0), a2, voffA);
            PG8_BAR; PG8_WAIT_L(0); PG8_MMA(1, 0, At, B0); PG8_BAR; PG8_SCHED;
            PG8_STAGE(PG8_SB(0, 1), b2 + hstep, voffB);
            PG8_WAIT_V(6); PG8_BAR; PG8_MMA(1, 1, At, B1); PG8_BAR;
            PG8_LDB(B0, 1, 0); PG8_SCHED; PG8_LDA(At, 1, 0); PG8_STAGE(PG8_SA(0, 1), a2 + hstep, voffA);
            PG8_WAIT_L(8); PG8_BAR; PG8_WAIT_L(0); PG8_MMA(0, 0, At, B0); PG8_BAR; PG8_SCHED;
            PG8_LDB(B1, 1, 1); PG8_STAGE(PG8_SB(1, 0), b3, voffB);
            PG8_BAR; PG8_WAIT_L(0); PG8_MMA(0, 1, At, B1); PG8_BAR;
            PG8_LDA(At, 1, 1); PG8_STAGE(PG8_SA(1, 0), a3, voffA);
            PG8_BAR; PG8_WAIT_L(0); PG8_MMA(1, 0, At, B0); PG8_BAR; PG8_SCHED;
            PG8_STAGE(PG8_SB(1, 1), b3 + hstep, voffB);
            PG8_WAIT_V(6); PG8_BAR; PG8_MMA(1, 1, At, B1); PG8_BAR;
            }
        }
        if constexpr (ALIGN_EPI) { if (wr == 0) PG8_BAR; }
        if constexpr (!Epi::AFTER_DRAIN) { E(acc, cur, wr, wc, fr, fq); S.done(cur); }
        if (!has_next) break;
#pragma unroll
        for (int a = 0; a < 2; ++a)
#pragma unroll
            for (int b = 0; b < 2; ++b)
#pragma unroll
                for (int m = 0; m < 4; ++m)
#pragma unroll
                    for (int n = 0; n < 2; ++n) acc[a][b][m][n] = (f32x4){0.f, 0.f, 0.f, 0.f};
        cur = nxt; cA = nA; cB = nB; ++ui;
        if constexpr (ALIGN_EPI) { if (wr == 1) PG8_BAR; }
    }
    PG8_WAIT_V(0);
    if constexpr (!ALIGN_EPI) { if (wr == 0) PG8_BAR; }
    PG8_BAR;
    if constexpr (Epi::AFTER_DRAIN) { E.fused(acc, cur, wr, wc, fr, fq, lds, wid, lane); S.done(cur); }
#undef PG8_SA
#undef PG8_SB
#undef PG8_STAGE
#undef PG8_LDA
#undef PG8_LDB
#undef PG8_MMA
#undef PG8_WAIT_V
#undef PG8_WAIT_L
#undef PG8_BAR
#undef PG8_SCHED
}
}

using pg8::bf16_t; using pg8::bf16x8; using pg8::f32x4; using pg8::u32x4; using pg8::Unit;
typedef float f32x16 __attribute__((ext_vector_type(16)));
typedef float f32x2v __attribute__((ext_vector_type(2)));
typedef short s16x4 __attribute__((ext_vector_type(4)));
typedef unsigned u32x2 __attribute__((ext_vector_type(2)));
#define LAS __attribute__((address_space(3)))
#define GAS __attribute__((address_space(1)))

constexpr int DM = 2048, NB = 4, SEQ = 2048, DEPTH = 2, DB = 16, DS = 64, PAST = 4096;
constexpr int NH = 8, HD = 128, DA = 1024, DC = 1024, CW = 31, DIN = 11272, NIN = 11264;
constexpr int MP = NB * SEQ, MS = DB * DS, MT = MP + MS, NSEQ = NB + DB;
constexpr float EPS = 1e-6f;
constexpr int NWAVES = 8, NTHR = 512;
constexpr size_t O_YP = 0, O_YS = 16777216, O_KP = 18874368, O_VP = 35651584, O_FP = 52428800, O_CP = 52559872,
                 O_KS = 52805632, O_VS = 54902784, O_FS = 56999936, O_CS = 57016320, O_END = 57999360;
constexpr size_t MiB = 1u << 20;
constexpr size_t WS_CTL = 0, CTL_ZERO_BYTES = 1 * MiB;
constexpr size_t WS_WF = 1 * MiB;
constexpr size_t WS_MOD = 2 * MiB;
constexpr size_t WS_FC = 4 * MiB;
constexpr size_t WS_WIN = 8 * MiB;
constexpr size_t WS_WOAB = 96 * MiB;
constexpr size_t WS_WOUT = 112 * MiB;
constexpr size_t WS_H = 128 * MiB;
constexpr size_t WS_Q = 164 * MiB, WS_K = 183 * MiB, WS_V = 202 * MiB;
constexpr size_t WS_GA = 221 * MiB, WS_U = 239 * MiB, WS_GB = 257 * MiB;
constexpr size_t WS_SA = 275 * MiB, WS_SB = 311 * MiB;
constexpr size_t WS_YAB = 347 * MiB;
constexpr size_t WS_END = 383 * MiB;
constexpr int CW_BAR = 4096;
constexpr int RING_BYTES = 131072;
constexpr int XS_OFF = RING_BYTES;
constexpr int LDS_BYTES = 163840;
constexpr int MISC_OFF = LDS_BYTES - 256;

__device__ __forceinline__ float wave_sum(float v) {
#pragma unroll
    for (int o = 1; o < 64; o <<= 1) v += __shfl_xor(v, o);
    return v;
}
__device__ __forceinline__ unsigned cvtpk(float lo, float hi) { unsigned r; asm volatile("v_cvt_pk_bf16_f32 %0, %1, %2" : "=v"(r) : "v"(lo), "v"(hi)); return r; }
__device__ __forceinline__ float bf_lo(unsigned u) { return __uint_as_float(u << 16); }
__device__ __forceinline__ float bf_hi(unsigned u) { return __uint_as_float(u & 0xffff0000u); }
__device__ __forceinline__ float fsigmoid(float x) { return __builtin_amdgcn_rcpf(1.0f + __builtin_amdgcn_exp2f(-1.4426950408889634f * x)); }
__device__ __forceinline__ u32x4 pack8f(f32x4 a, f32x4 b) { u32x4 w = {cvtpk(a[0], a[1]), cvtpk(a[2], a[3]), cvtpk(b[0], b[1]), cvtpk(b[2], b[3])}; return w; }
__device__ __forceinline__ int seq_of_row(int m) { return m < MP ? (m >> 11) : NB + ((m - MP) >> 6); }

struct EpiIn {
    static constexpr bool PERM = true, AFTER_DRAIN = false, HAS_MID = false;
    unsigned char* ws; float* out; int layer; const float *qg, *kg; LAS float* xs;
    __device__ __forceinline__ void st8(bf16_t* p, f32x4 a, f32x4 b) const { *(u32x4*)p = pack8f(a, b); }
    __device__ __forceinline__ void operator()(const f32x4 (&acc)[2][2][4][2], const Unit& u, int wr, int wc, int fr, int fq) const {
        const int pn = u.pn, cw = wc * 32 + 8 * fq;
        const int rbase = u.pm * 256 + wr * 64 + fr;
        const bool prompt = u.pm < 32;
        if (pn < 8) {
            const bool isk = pn >= 4; const int hp = (pn & 3) * 2;
#pragma unroll
            for (int ai = 0; ai < 2; ++ai)
#pragma unroll
                for (int m = 0; m < 4; ++m)
#pragma unroll
                    for (int bj = 0; bj < 2; ++bj) {
                        const f32x4 a = acc[ai][bj][m][0], b = acc[ai][bj][m][1];
                        float s = (a[0] * a[0] + a[1] * a[1]) + (a[2] * a[2] + a[3] * a[3]) + (b[0] * b[0] + b[1] * b[1]) + (b[2] * b[2] + b[3] * b[3]);
                        s += __shfl_xor(s, 16); s += __shfl_xor(s, 32);
                        if (fq == 0) xs[((wr * 4 + wc) * 128 + ai * 64 + m * 16 + fr) * 2 + bj] = s;
                    }
            asm volatile("s_waitcnt lgkmcnt(0)" ::: "memory"); __builtin_amdgcn_s_barrier(); asm volatile("" ::: "memory");
            const float* g = isk ? kg : qg; const f32x4 g0 = *(const f32x4*)(g + cw), g1 = *(const f32x4*)(g + cw + 4);
            bf16_t* dst = (bf16_t*)(ws + (isk ? WS_K : WS_Q));
            float* fo = prompt ? out + O_KP + (size_t)layer * (MP * 1024) : out + O_KS + (size_t)layer * (MS * 1024) - (size_t)MP * 1024;
#pragma unroll
            for (int ai = 0; ai < 2; ++ai)
#pragma unroll
                for (int m = 0; m < 4; ++m) {
                    const int row = rbase + ai * 128 + m * 16;
#pragma unroll
                    for (int bj = 0; bj < 2; ++bj) {
                        const int xi = (wr * 4 * 128 + ai * 64 + m * 16 + fr) * 2 + bj;
                        const float tot = (xs[xi] + xs[xi + 256]) + (xs[xi + 512] + xs[xi + 768]);
                        const float rstd = __builtin_amdgcn_rsqf(tot * (1.0f / 128.0f) + EPS);
                        const f32x4 a = acc[ai][bj][m][0] * rstd * g0, b = acc[ai][bj][m][1] * rstd * g1;
                        const size_t o = (size_t)row * 1024 + (hp + bj) * 128 + cw;
                        st8(dst + o, a, b);
                        if (isk) { *(f32x4*)(fo + o) = a; *(f32x4*)(fo + o + 4) = b; }
                    }
                }
        } else if (pn < 12) {
            float* fo = prompt ? out + O_VP + (size_t)layer * (MP * 1024) : out + O_VS + (size_t)layer * (MS * 1024) - (size_t)MP * 1024;
#pragma unroll
            for (int ai = 0; ai < 2; ++ai)
#pragma unroll
                for (int m = 0; m < 4; ++m) {
                    const int row = rbase + ai * 128 + m * 16;
#pragma unroll
                    for (int bj = 0; bj < 2; ++bj) {
                        const f32x4 a = acc[ai][bj][m][0], b = acc[ai][bj][m][1];
                        const size_t o = (size_t)row * 1024 + (pn - 8) * 256 + bj * 128 + cw;
                        st8((bf16_t*)(ws + WS_V) + o, a, b); *(f32x4*)(fo + o) = a; *(f32x4*)(fo + o + 4) = b;
                    }
                }
        } else if (pn >= 16 && pn < 24) {
#pragma unroll
            for (int ai = 0; ai < 2; ++ai)
#pragma unroll
                for (int m = 0; m < 4; ++m) {
                    const int row = rbase + ai * 128 + m * 16;
                    f32x4 a = acc[ai][0][m][0], b = acc[ai][0][m][1]; const f32x4 ga = acc[ai][1][m][0], gb = acc[ai][1][m][1];
#pragma unroll
                    for (int i = 0; i < 4; ++i) { a[i] *= fsigmoid(ga[i]); b[i] *= fsigmoid(gb[i]); }
                    const int ch = (pn - 16) * 128 + cw;
                    st8((bf16_t*)(ws + WS_U) + (size_t)row * 1024 + ch, a, b);
                    int tl, sb; float* co;
                    if (prompt) { tl = (row & 2047) - (SEQ - 30); sb = row >> 11; co = out + O_CP + (size_t)layer * (NB * 30 * 1024); }
                    else { const int r2 = row - MP; tl = (r2 & 63) - (DS - 30); sb = r2 >> 6; co = out + O_CS + (size_t)layer * (DB * 30 * 1024); }
                    if (tl >= 0) { float* p = co + ((size_t)sb * 30 + tl) * 1024 + ch; *(f32x4*)p = a; *(f32x4*)(p + 4) = b; }
                }
        } else {
            const bool gate = pn >= 28;
            size_t woff; int ld, c0;
            if (pn < 16) { woff = WS_GA; ld = 1024; c0 = (pn - 12) * 256; }
            else if (pn < 28) { woff = WS_GB; ld = 1024; c0 = (pn - 24) * 256; }
            else if (pn < 36) { woff = WS_SA; ld = 2048; c0 = (pn - 28) * 256; }
            else { woff = WS_SB; ld = 2048; c0 = (pn - 36) * 256; }
            bf16_t* dst = (bf16_t*)(ws + woff);
#pragma unroll
            for (int ai = 0; ai < 2; ++ai)
#pragma unroll
                for (int m = 0; m < 4; ++m) {
                    const int row = rbase + ai * 128 + m * 16;
#pragma unroll
                    for (int bj = 0; bj < 2; ++bj) {
                        f32x4 a = acc[ai][bj][m][0], b = acc[ai][bj][m][1];
#pragma unroll
                        for (int i = 0; i < 4; ++i) { const float sa = fsigmoid(a[i]), sb = fsigmoid(b[i]); a[i] = gate ? sa : a[i] * sa; b[i] = gate ? sb : b[i] * sb; }
                        st8(dst + (size_t)row * ld + c0 + bj * 128 + cw, a, b);
                    }
                }
        }
    }
};
#ifndef MIDG
#define MIDG 4
#endif
struct EpiMerge {
    static constexpr bool PERM = true, AFTER_DRAIN = false, HAS_MID = true;
    const bf16_t *SA, *SB; bf16_t* MG;
    __device__ __forceinline__ void mid(f32x4 (&acc)[2][2][4][2], const Unit& u, int wr, int wc, int fr, int fq) const {
        int fr_ = fr; asm volatile("" : "+v"(fr_));
        const unsigned voff = (unsigned)(((wr * 64 + fr_) * 2048 + wc * 32 + 8 * fq) * 2);
        const size_t uoff = ((size_t)u.pm * 256 * 2048 + (size_t)u.pn * 256) * 2;
        const bf16_t* pa = (const bf16_t*)((const char*)SA + uoff + voff); const bf16_t* pb = (const bf16_t*)((const char*)SB + uoff + voff);
#pragma unroll
        for (int ai = 0; ai < 2; ++ai)
#pragma unroll
            for (int mp = 0; mp < 4; mp += MIDG) {
                u32x4 sa[MIDG][2], sb[MIDG][2];
#pragma unroll
                for (int q = 0; q < MIDG; ++q)
#pragma unroll
                    for (int bj = 0; bj < 2; ++bj) { const size_t o = (size_t)(ai * 128 + (mp + q) * 16) * 2048 + bj * 128; sa[q][bj] = *(const u32x4*)(pa + o); sb[q][bj] = *(const u32x4*)(pb + o); }
#pragma unroll
                for (int q = 0; q < MIDG; ++q)
#pragma unroll
                    for (int bj = 0; bj < 2; ++bj)
#pragma unroll
                        for (int j = 0; j < 4; ++j) {
                            const float r0 = bf_lo(sa[q][bj][j]) * __builtin_amdgcn_rcpf(bf_lo(sb[q][bj][j])), r1 = bf_hi(sa[q][bj][j]) * __builtin_amdgcn_rcpf(bf_hi(sb[q][bj][j]));
                            acc[ai][bj][mp + q][j >> 1][(j & 1) * 2] *= r0; acc[ai][bj][mp + q][j >> 1][(j & 1) * 2 + 1] *= r1;
                        }
#pragma unroll
                for (int q = 0; q < MIDG; ++q) asm volatile("" : "+v"(acc[ai][0][mp + q][0]), "+v"(acc[ai][0][mp + q][1]), "+v"(acc[ai][1][mp + q][0]), "+v"(acc[ai][1][mp + q][1]));
                asm volatile("" ::: "memory");
            }
    }
    __device__ __forceinline__ void operator()(const f32x4 (&acc)[2][2][4][2], const Unit& u, int wr, int wc, int fr, int fq) const {
        const int cw = wc * 32 + 8 * fq, rbase = u.pm * 256 + wr * 64 + fr;
#pragma unroll
        for (int ai = 0; ai < 2; ++ai)
#pragma unroll
            for (int m = 0; m < 4; ++m) {
                const int row = rbase + ai * 128 + m * 16;
#pragma unroll
                for (int bj = 0; bj < 2; ++bj) {
                    const size_t o = (size_t)row * 2048 + u.pn * 256 + bj * 128 + cw;
                    const u32x4 sb = *(const u32x4*)(SB + o);
                    f32x4 a = acc[ai][bj][m][0], b = acc[ai][bj][m][1];
                    a[0] *= bf_lo(sb[0]); a[1] *= bf_hi(sb[0]); a[2] *= bf_lo(sb[1]); a[3] *= bf_hi(sb[1]);
                    b[0] *= bf_lo(sb[2]); b[1] *= bf_hi(sb[2]); b[2] *= bf_lo(sb[3]); b[3] *= bf_hi(sb[3]);
                    *(u32x4*)(MG + o) = pack8f(a, b);
                }
                if (m & 1) asm volatile("" ::: "memory");
            }
    }
};
struct EpiOut {
    static constexpr bool PERM = false, AFTER_DRAIN = false, HAS_MID = false;
    const float* xp; const float* xsm; float* y; const float* gate;
    __device__ __forceinline__ void operator()(const f32x4 (&acc)[2][2][4][2], const Unit& u, int wr, int wc, int fr, int fq) const {
        const int rbase = u.pm * 256 + wr * 64 + fr, col0 = u.pn * 256 + wc * 32 + 4 * fq;
#pragma unroll
        for (int ai = 0; ai < 2; ++ai) {
            const int s = seq_of_row(u.pm * 256 + ai * 128 + wr * 64);
            f32x4 g[2][2];
#pragma unroll
            for (int bj = 0; bj < 2; ++bj)
#pragma unroll
                for (int n = 0; n < 2; ++n) g[bj][n] = *(const f32x4*)(gate + (size_t)s * 6144 + col0 + bj * 128 + n * 16);
#pragma unroll
            for (int m = 0; m < 4; ++m) {
                const int row = rbase + ai * 128 + m * 16;
                const float* xr = (row < MP) ? xp + (size_t)row * DM : xsm + (size_t)(row - MP) * DM;
                float* yr = y + (size_t)row * DM;
#pragma unroll
                for (int bj = 0; bj < 2; ++bj)
#pragma unroll
                    for (int n = 0; n < 2; ++n) { const int c = col0 + bj * 128 + n * 16; const f32x4 xv = *(const f32x4*)(xr + c); *(f32x4*)(yr + c) = xv + g[bj][n] * acc[ai][bj][m][n]; }
            }
        }
    }
};
#define XB_TMO      128
#define XB_XCNT(j)  (256  + 64 * (j))
#define XB_XSUB(j)  (1280 + 64 * (j))
#define XB_XGEN(j)  (2304 + 64 * (j))
#define XB_TOP      3328
#define XB_TOPGEN   3392
#define XCD_BAR_WORDS 3456
#define XB_SPIN_CAP (1u << 18)

__device__ __forceinline__ unsigned xb_ld(unsigned* p)              { return __hip_atomic_load(p, __ATOMIC_RELAXED, __HIP_MEMORY_SCOPE_AGENT); }
__device__ __forceinline__ unsigned xb_add(unsigned* p, unsigned v) { return __hip_atomic_fetch_add(p, v, __ATOMIC_RELAXED, __HIP_MEMORY_SCOPE_AGENT); }
__device__ __forceinline__ unsigned xb_xcc_id() { return (unsigned)__builtin_amdgcn_s_getreg((3 << 11) | 20) & 0xFu; }
#define XB_SPIN(cond, bar) do { unsigned _sp = 0; while (cond) { __builtin_amdgcn_s_sleep(1); \
    if ((++_sp & 255u) == 0u) { if (xb_ld(&(bar)[XB_TMO])) break; if (_sp > XB_SPIN_CAP) { atomicAdd(&(bar)[XB_TMO], 1u); break; } } } } while (0)

struct XcdBarrier {
    unsigned* bar; unsigned x;
    volatile LAS unsigned* st;
};

__device__ __forceinline__ XcdBarrier xcd_barrier_post(unsigned* bar, volatile LAS unsigned* st) {
    XcdBarrier b; b.bar = bar; b.x = xb_xcc_id(); b.st = st;
    if (threadIdx.x == 0) (void)xb_add(&bar[XB_XCNT(b.x)], 1u);
    return b;
}
__device__ __forceinline__ void xcd_barrier_complete(unsigned* bar, unsigned x, unsigned& nloc, unsigned& nx) {
    const unsigned G = gridDim.x * gridDim.y * gridDim.z;
    unsigned sum, cnt, mine, sp = 0u;
    for (;;) {
        sum = 0u; cnt = 0u; mine = 0u;
#pragma unroll
        for (unsigned j = 0; j < 16; ++j) { const unsigned c = xb_ld(&bar[XB_XCNT(j)]); sum += c; cnt += (c > 0u) ? 1u : 0u; mine = (j == x) ? c : mine; }
        if (sum == G) break;
        __builtin_amdgcn_s_sleep(1);
        if ((++sp & 255u) == 0u) { if (xb_ld(&bar[XB_TMO])) break; if (sp > XB_SPIN_CAP) { atomicAdd(&bar[XB_TMO], 1u); break; } }
    }
    nloc = mine > 0u ? mine : 1u; nx = cnt > 0u ? cnt : 1u;
}

__device__ __forceinline__ void xcd_barrier(const XcdBarrier& b) {
    asm volatile("s_waitcnt vmcnt(0)" ::: "memory");
    __syncthreads();
    if (threadIdx.x == 0) {
        unsigned* bar = b.bar;
        __builtin_amdgcn_s_waitcnt(0);
        unsigned nloc = b.st[0], nx = b.st[1];
        if (nloc == 0u) { xcd_barrier_complete(bar, b.x, nloc, nx); b.st[0] = nloc; b.st[1] = nx; }
        const unsigned old = xb_add(&bar[XB_XSUB(b.x)], 1u);
        const unsigned gen = old / nloc;
        if (old + 1u == (gen + 1u) * nloc) {
            __builtin_amdgcn_fence(__ATOMIC_RELEASE, "agent");
            asm volatile("s_waitcnt vmcnt(0)" ::: "memory");
            const unsigned og = xb_add(&bar[XB_TOP], 1u);
            const unsigned tg = og / nx;
            if (og + 1u == (tg + 1u) * nx) xb_add(&bar[XB_TOPGEN], 1u);
            else XB_SPIN(xb_ld(&bar[XB_TOPGEN]) == tg, bar);
            __builtin_amdgcn_fence(__ATOMIC_ACQUIRE, "agent");
            xb_add(&bar[XB_XGEN(b.x)], 1u);
            asm volatile("s_waitcnt vmcnt(0)" ::: "memory");
        } else {
            XB_SPIN(xb_ld(&bar[XB_XGEN(b.x)]) == gen, bar);
            __builtin_amdgcn_fence(__ATOMIC_ACQUIRE, "agent");
            asm volatile("s_waitcnt vmcnt(0)" ::: "memory");
        }
    }
    __syncthreads();
}

namespace fa {
constexpr int D = 128, NW = 8, QBLK = 32, KVBLK = 64, QB = NW * QBLK;
constexpr int SHM_V = KVBLK * D * 2, SHM_K = KVBLK * D * 2;
constexpr int OFF_WS = 2 * SHM_V + 2 * SHM_K, OFF_BIAS = OFF_WS + NW * 64 * 4, OFF_RED = OFF_BIAS + 4224 * 4, OFF_OST = OFF_RED + 256, LDS_BYTES = OFF_OST + NW * 8192;
constexpr float SCALE = 0.08838834764831845f, INV_SCALE = 11.313708498984761f, THR = 8.f;
constexpr int RS = 1024;
constexpr int OS = 2048;
template <class A, class Bt> struct same_t { static constexpr bool v = false; };
template <class A> struct same_t<A, A> { static constexpr bool v = true; };
#define KSWZ(row, colB) ((row) * 256 + ((colB) ^ (((row) & 7) << 4)))
#define SBAR() __builtin_amdgcn_sched_barrier(0)
__device__ __forceinline__ int v_st(int k, int c) { const int kk = (k & ~0xC) | ((k & 4) << 1) | ((k & 8) >> 1); return ((kk >> 3) * 4 + (c >> 5)) * 512 + ((kk & 7) * 32 + (c & 31)) * 2; }
__device__ __forceinline__ int v_rd_base(int lane) { return ((lane & 3) << 3) | (((lane >> 2) & 3) << 6) | (((lane >> 4) & 1) << 5) | (((lane >> 5) & 1) << 8); }
constexpr int v_rd_off(int d0, int ks, int half) { return d0 * 512 + ks * 4096 + half * 2048; }
__device__ __forceinline__ int crow(int r, int hi) { return (r & 3) + 8 * (r >> 2) + 4 * hi; }
__device__ __forceinline__ bf16x8 pack8(f32x4 a, f32x4 b) { u32x4 w = {cvtpk(a[0], a[1]), cvtpk(a[2], a[3]), cvtpk(b[0], b[1]), cvtpk(b[2], b[3])}; return *reinterpret_cast<bf16x8*>(&w); }
__device__ __forceinline__ void mask_tile(f32x16& p0, f32x16& p1, int dq) {
    const float NEG = -__builtin_inff();
#pragma unroll
    for (int r = 0; r < 16; ++r) { const int c = (r & 3) + 8 * (r >> 2); if (dq - c < 0) p0[r] = NEG; if (dq - c - 32 < 0) p1[r] = NEG; }
}
__device__ __forceinline__ void partialSM(f32x16& p0, f32x16& p1, float& m_reg, float& mn, float& alpha) {
    float pmax = p0[0];
#pragma unroll
    for (int r = 1; r < 16; ++r) pmax = fmaxf(pmax, p0[r]);
#pragma unroll
    for (int r = 0; r < 16; ++r) pmax = fmaxf(pmax, p1[r]);
    { auto rr = __builtin_amdgcn_permlane32_swap(__float_as_uint(pmax), __float_as_uint(pmax), false, false); pmax = fmaxf(__uint_as_float(rr[0]), __uint_as_float(rr[1])); }
    constexpr float C2 = 1.4426950408889634f * SCALE;
    if (__builtin_expect(__all((pmax - m_reg) * SCALE <= THR), 1)) { mn = m_reg; alpha = 1.f; }
    else { mn = fmaxf(m_reg, pmax); alpha = __builtin_amdgcn_exp2f((m_reg - mn) * C2); m_reg = mn; }
    const float mnL = -mn * C2;
#pragma unroll
    for (int r = 0; r < 16; ++r) p0[r] = fmaf(p0[r], C2, mnL);
#pragma unroll
    for (int r = 0; r < 16; ++r) p1[r] = fmaf(p1[r], C2, mnL);
#pragma unroll
    for (int r = 0; r < 16; ++r) p0[r] = __builtin_amdgcn_exp2f(p0[r]);
}
__device__ __forceinline__ void finishSM(f32x16& p0, f32x16& p1, float alpha, float& l_reg, bf16x8& pa0, bf16x8& pa1, bf16x8& pa2, bf16x8& pa3) {
#pragma unroll
    for (int r = 0; r < 16; ++r) p1[r] = __builtin_amdgcn_exp2f(p1[r]);
    float ps = 0;
#pragma unroll
    for (int r = 0; r < 16; ++r) ps += p0[r];
#pragma unroll
    for (int r = 0; r < 16; ++r) ps += p1[r];
    { auto rr = __builtin_amdgcn_permlane32_swap(__float_as_uint(ps), __float_as_uint(ps), false, false); ps = __uint_as_float(rr[0]) + __uint_as_float(rr[1]); }
    l_reg = l_reg * alpha + ps;
#define PK4(P, B_, OUT) do { unsigned a0 = cvtpk(P[B_+0], P[B_+1]), a1 = cvtpk(P[B_+2], P[B_+3]);                          \
        unsigned b0 = cvtpk(P[B_+4], P[B_+5]), b1 = cvtpk(P[B_+6], P[B_+7]);                                             \
        auto r0 = __builtin_amdgcn_permlane32_swap(a0, b0, false, false); auto r1 = __builtin_amdgcn_permlane32_swap(a1, b1, false, false); \
        u32x4 w = {r0[0], r1[0], r0[1], r1[1]}; OUT = *reinterpret_cast<bf16x8*>(&w); } while (0)
    PK4(p0, 0, pa0); PK4(p0, 8, pa1); PK4(p1, 0, pa2); PK4(p1, 8, pa3);
#undef PK4
}
template <int KB>
__device__ __forceinline__ void qkt(f32x16& p0, f32x16& p1, const char* K_lds, const float* cb, int r32, int hi, const bf16x8* qr) {
    const f32x4* c4 = (const f32x4*)(cb + 4 * hi);
#pragma unroll
    for (int g = 0; g < 4; ++g) { const f32x4 a = c4[2 * g], b = c4[2 * g + 8];
        p0[4 * g] = a[0]; p0[4 * g + 1] = a[1]; p0[4 * g + 2] = a[2]; p0[4 * g + 3] = a[3];
        p1[4 * g] = b[0]; p1[4 * g + 1] = b[1]; p1[4 * g + 2] = b[2]; p1[4 * g + 3] = b[3]; }
    const char* kb[4];
#pragma unroll
    for (int dd = 0; dd < 4; ++dd) kb[dd] = K_lds + KB * SHM_K + KSWZ(r32, (dd * 16 + hi * 8) * 2);
#pragma unroll
    for (int d0 = 0; d0 < 8; ++d0) { const char* a = kb[d0 & 3] + (d0 >> 2) * 128;
        bf16x8 b0 = *reinterpret_cast<const bf16x8*>(a);
        bf16x8 b1 = *reinterpret_cast<const bf16x8*>(a + 32 * 256);
        p0 = __builtin_amdgcn_mfma_f32_32x32x16_bf16(b0, qr[d0], p0, 0, 0, 0);
        p1 = __builtin_amdgcn_mfma_f32_32x32x16_bf16(b1, qr[d0], p1, 0, 0, 0); }
}
template <int VB>
__device__ __forceinline__ void pv_tile(f32x16* o, int vb0, bf16x8 pa0, bf16x8 pa1, bf16x8 pa2, bf16x8 pa3) {
#define TRRD(dst, off) asm volatile("ds_read_b64_tr_b16 %0, %1 offset:%2" : "=&v"(dst) : "v"(vb0), "i"(off) : "memory")
#define PV_D0(d0) do { s16x4 l0, l1, l2, l3, h0, h1, h2, h3; constexpr int b_ = VB * SHM_V + v_rd_off(d0, 0, 0); \
        TRRD(l0, b_); TRRD(h0, b_ + 2048); TRRD(l1, b_ + 4096); TRRD(h1, b_ + 6144); TRRD(l2, b_ + 8192); TRRD(h2, b_ + 10240); TRRD(l3, b_ + 12288); TRRD(h3, b_ + 14336); \
        asm volatile("s_waitcnt lgkmcnt(0)" ::: "memory"); SBAR();   \
        o[d0] = __builtin_amdgcn_mfma_f32_32x32x16_bf16(pa0, (bf16x8){l0[0], l0[1], l0[2], l0[3], h0[0], h0[1], h0[2], h0[3]}, o[d0], 0, 0, 0);   \
        o[d0] = __builtin_amdgcn_mfma_f32_32x32x16_bf16(pa1, (bf16x8){l1[0], l1[1], l1[2], l1[3], h1[0], h1[1], h1[2], h1[3]}, o[d0], 0, 0, 0);   \
        o[d0] = __builtin_amdgcn_mfma_f32_32x32x16_bf16(pa2, (bf16x8){l2[0], l2[1], l2[2], l2[3], h2[0], h2[1], h2[2], h2[3]}, o[d0], 0, 0, 0);   \
        o[d0] = __builtin_amdgcn_mfma_f32_32x32x16_bf16(pa3, (bf16x8){l3[0], l3[1], l3[2], l3[3], h3[0], h3[1], h3[2], h3[3]}, o[d0], 0, 0, 0); } while (0)
    PV_D0(0); PV_D0(1); PV_D0(2); PV_D0(3);
#undef PV_D0
#undef TRRD
}
template <class TKV> struct BlockRef { const bf16_t* Q; const TKV* K; const TKV* V; const TKV* K2; const TKV* V2; int nk1; bf16_t* O; const bf16_t* G; int P0; int live; };
struct Seam { bf16x8 qr[8]; bf16x8 st_v0, st_v1, st_k0, st_k1; f32x4 sf0, sf1, sf2, sf3; };
#define KPTR(ref, k0) ((k0) < (ref).nk1 ? (ref).K + (size_t)(k0) * RS : (ref).K2 + (size_t)((k0) - (ref).nk1) * RS)
#define VPTR(ref, k0) ((k0) < (ref).nk1 ? (ref).V + (size_t)(k0) * RS : (ref).V2 + (size_t)((k0) - (ref).nk1) * RS)
#define ROWP(p, rr) ((p) + (size_t)(rr) * RS + sc)
#define VMW() asm volatile("s_waitcnt vmcnt(0)" ::: "memory")
#define VMWN(n) asm volatile("s_waitcnt vmcnt(%0)" :: "i"(n) : "memory")
#define SLOAD_H(ref, k0) do { const TKV* kp_ = KPTR(ref, k0); const TKV* vp_ = VPTR(ref, k0);                                     \
        S.st_v0 = *(const bf16x8*)ROWP((const bf16_t*)vp_, sr); S.st_v1 = *(const bf16x8*)ROWP((const bf16_t*)vp_, 32 + sr);     \
        S.st_k0 = *(const bf16x8*)ROWP((const bf16_t*)kp_, sr); S.st_k1 = *(const bf16x8*)ROWP((const bf16_t*)kp_, 32 + sr); } while (0)
#define SWRITE_HK(bf) do { *(bf16x8*)(K_lds + (bf) * SHM_K + kws) = S.st_k0; *(bf16x8*)(K_lds + (bf) * SHM_K + kws + 32 * 256) = S.st_k1; } while (0)
#define SWRITE_HV(bf) do { *(bf16x8*)(V_lds + (bf) * SHM_V + vst0) = S.st_v0; *(bf16x8*)(V_lds + (bf) * SHM_V + vst1) = S.st_v1; } while (0)
#define SWRITE_H(bf) do { SWRITE_HV(bf); SWRITE_HK(bf); } while (0)
#define SLOAD_F(p_) do { const float* q_ = (const float*)(p_); S.sf0 = *(const f32x4*)ROWP(q_, sr); S.sf1 = *(const f32x4*)(ROWP(q_, sr) + 4);                \
                         S.sf2 = *(const f32x4*)ROWP(q_, 32 + sr); S.sf3 = *(const f32x4*)(ROWP(q_, 32 + sr) + 4); } while (0)
#define SWRITE_KF(bf) do { *(bf16x8*)(K_lds + (bf) * SHM_K + kws) = pack8(S.sf0, S.sf1); *(bf16x8*)(K_lds + (bf) * SHM_K + kws + 32 * 256) = pack8(S.sf2, S.sf3); } while (0)
#define SWRITE_VF(bf) do { *(bf16x8*)(V_lds + (bf) * SHM_V + vst0) = pack8(S.sf0, S.sf1); *(bf16x8*)(V_lds + (bf) * SHM_V + vst1) = pack8(S.sf2, S.sf3); } while (0)
template <class TKV>
__device__ __forceinline__ void attn_prime(const BlockRef<TKV>& cur, char* lds, Seam& S) {
    constexpr bool F32 = same_t<TKV, float>::v;
    const int tid = opaque_tid(), wid = __builtin_amdgcn_readfirstlane(tid >> 6), lane = tid & 63, r32 = lane & 31, hi = lane >> 5;
    const int sr = tid >> 4, sc = (tid & 15) * 8, kws = KSWZ(sr, sc * 2); char* K_lds = lds + 2 * SHM_V;
#pragma unroll
    for (int d0 = 0; d0 < 8; ++d0) S.qr[d0] = *(const bf16x8*)(cur.Q + (size_t)(wid * QBLK + r32) * RS + d0 * 16 + hi * 8);
    if constexpr (F32) { SLOAD_F(KPTR(cur, 0)); VMW(); SWRITE_KF(0); SBAR(); SLOAD_F(VPTR(cur, 0)); }
    else { SLOAD_H(cur, 0); VMW(); SWRITE_HK(0); }
    __syncthreads();
}
template <class TKV>
__device__ __forceinline__ void attn_block(const BlockRef<TKV>& cur, const BlockRef<TKV>& nxt, int skv, char* lds, Seam& S) {
    constexpr bool F32 = same_t<TKV, float>::v;
    const int tid = opaque_tid(), wid = __builtin_amdgcn_readfirstlane(tid >> 6), lane = tid & 63, r32 = lane & 31, hi = lane >> 5;
    int j_hi = (cur.P0 + QB - 1) / KVBLK + 1; if (j_hi > skv / KVBLK) j_hi = skv / KVBLK;
    const int NT = j_hi;
    const int qlo = cur.P0 + wid * QBLK, qm = qlo + r32 - 4 * hi;
    char* V_lds = lds; char* K_lds = lds + 2 * SHM_V;
    float* ws = (float*)(lds + OFF_WS) + wid * 64; float* li_l = ws, * al_l = ws + 32;
    const float* cbias = (const float*)(lds + OFF_BIAS);
    float m_reg = -1e30f, l_reg = 0; f32x16 o[4] = {};
    const int sr = tid >> 4, sc = (tid & 15) * 8, vst0 = v_st(sr, sc), vst1 = v_st(32 + sr, sc), kws = KSWZ(sr, sc * 2);
    const int vb0 = (int)(uintptr_t)V_lds + v_rd_base(lane);
#define RESC(a) do { if (__any((a) < 1.f)) { if (hi == 0) al_l[r32] = (a); asm volatile("s_waitcnt lgkmcnt(0)" ::: "memory");              \
                     for (int d_ = 0; d_ < 4; ++d_) for (int r = 0; r < 16; ++r) o[d_][r] *= al_l[crow(r, hi)]; } } while (0)
#define KBASE(t) ((t) * KVBLK)
#define MASKT(P0_, P1_, t) do { const int kb_ = KBASE(t); if (kb_ + KVBLK - 1 > qlo) mask_tile(P0_, P1_, qm - kb_); } while (0)
    constexpr int NQL = 8;
#define SEAM_K0() do { VMWN(NQL); if constexpr (F32) { SWRITE_KF(0); SBAR(); SLOAD_F(VPTR(nxt, 0)); } else { SWRITE_HK(0); } SBAR(); } while (0)
    f32x16 pA0, pA1, pB0, pB1; float mnA, mnB, alA, alB; bf16x8 pa0, pa1, pa2, pa3;
    if constexpr (F32) { VMW(); SWRITE_VF(0); SBAR(); } else { SWRITE_HV(0); SBAR(); }
    if (NT > 1) { if constexpr (F32) SLOAD_F(KPTR(cur, KBASE(1))); else SLOAD_H(cur, KBASE(1)); }
    SBAR(); qkt<0>(pA0, pA1, K_lds, cbias, r32, hi, S.qr);
    if constexpr (F32) { if (NT > 1) { VMW(); SWRITE_KF(1); SBAR(); SLOAD_F(VPTR(cur, KBASE(1))); } }
    MASKT(pA0, pA1, 0); partialSM(pA0, pA1, m_reg, mnA, alA);
    if (NT > 1) { VMW(); if constexpr (F32) { SWRITE_VF(1); SBAR(); if (NT > 2) SLOAD_F(KPTR(cur, KBASE(2))); } else SWRITE_H(1); }
    __syncthreads();
#define HALF_STEP(PX0, PX1, mnX, alX, PY0, PY1, alY, t, KB, VB, SB) do {                                                      \
        SBAR(); qkt<KB>(PX0, PX1, K_lds, cbias + KBASE(t), r32, hi, S.qr);                                                    \
        finishSM(PY0, PY1, alY, l_reg, pa0, pa1, pa2, pa3); SBAR();                                                           \
        if ((t) + 1 < NT) { if constexpr (F32) { VMW(); SWRITE_KF(SB); SBAR(); SLOAD_F(VPTR(cur, KBASE((t) + 1))); }          \
                            else { SLOAD_H(cur, KBASE((t) + 1)); } SBAR(); }                                                  \
        pv_tile<VB>(o, vb0, pa0, pa1, pa2, pa3); MASKT(PX0, PX1, (t)); partialSM(PX0, PX1, m_reg, mnX, alX);                  \
        __syncthreads();                                                                                                      \
        if ((t) + 1 < NT) { VMW(); if constexpr (F32) { SWRITE_VF(SB); SBAR(); if ((t) + 2 < NT) SLOAD_F(KPTR(cur, KBASE((t) + 2))); } \
                            else { SWRITE_H(SB); } }                                                                          \
        RESC(alX); __syncthreads(); } while (0)
    for (int t = 1; t + 1 < NT; t += 2) {
        HALF_STEP(pB0, pB1, mnB, alB, pA0, pA1, alA, t, 1, 0, 0);
        HALF_STEP(pA0, pA1, mnA, alA, pB0, pB1, alB, t + 1, 0, 1, 1);
    }
    const bool even = (NT & 1) == 0;
    if (even) { SBAR(); qkt<1>(pB0, pB1, K_lds, cbias + KBASE(NT - 1), r32, hi, S.qr); SBAR(); }
    if constexpr (F32) { SLOAD_F(KPTR(nxt, 0)); SBAR(); } else { SLOAD_H(nxt, 0); SBAR(); }
#pragma unroll
    for (int d0 = 0; d0 < 8; ++d0) S.qr[d0] = *(const bf16x8*)(nxt.Q + (size_t)(wid * QBLK + r32) * RS + d0 * 16 + hi * 8);
    SBAR();
    finishSM(pA0, pA1, alA, l_reg, pa0, pa1, pa2, pa3); SBAR();
    pv_tile<0>(o, vb0, pa0, pa1, pa2, pa3);
    if (even) { MASKT(pB0, pB1, NT - 1); partialSM(pB0, pB1, m_reg, mnB, alB); __syncthreads(); RESC(alB);
        finishSM(pB0, pB1, alB, l_reg, pa0, pa1, pa2, pa3); SBAR(); pv_tile<1>(o, vb0, pa0, pa1, pa2, pa3); }
    SBAR(); SEAM_K0();
    if (hi == 0) li_l[r32] = l_reg; asm volatile("s_waitcnt lgkmcnt(0)" ::: "memory");
    if (wid * QBLK < cur.live) {
        int e_ = lane; asm volatile("" : "+v"(e_));
        const int erow = e_ >> 4, ech = (e_ & 15) * 8, er32 = e_ & 31, ehi = e_ >> 5;
        bf16_t* stg = (bf16_t*)(lds + OFF_OST) + wid * 4096;
        const bf16_t* gp = cur.G + (size_t)(wid * QBLK + erow) * RS + ech; bf16_t* op = cur.O + (size_t)(wid * QBLK + erow) * OS + ech;
        bf16_t* sp0 = stg + erow * 128 + ech;
#pragma unroll
        for (int i = 0; i < 8; ++i) { *(u32x4*)(sp0 + i * 512) = *(const u32x4*)gp; gp += 4 * RS; }
        asm volatile("s_waitcnt lgkmcnt(0)" ::: "memory");
        bf16_t* sq = stg + ehi * 512 + er32; const float* lq = li_l + 4 * ehi;
#pragma unroll
        for (int r = 0; r < 16; ++r) { const int oc = (r & 3) + 8 * (r >> 2); const float rl = __builtin_amdgcn_rcpf(lq[oc]);
#pragma unroll
            for (int d0 = 0; d0 < 4; ++d0) { bf16_t* sp = sq + oc * 128 + d0 * 32; const float g = __uint_as_float((unsigned)(*sp) << 16);
                *sp = (bf16_t)(cvtpk(o[d0][r] * rl * g, 0.f) & 0xffffu); } }
        asm volatile("s_waitcnt lgkmcnt(0)" ::: "memory");
#pragma unroll
        for (int i = 0; i < 8; ++i) { *(u32x4*)op = *(const u32x4*)(sp0 + i * 512); op += 4 * OS; }
    }
    __syncthreads();
#undef RESC
#undef KBASE
#undef MASKT
#undef SEAM_K0
#undef HALF_STEP
}
#undef ROWP
#undef VMW
#undef VMWN
#undef SLOAD_H
#undef SWRITE_HK
#undef SWRITE_HV
#undef SWRITE_H
#undef SLOAD_F
#undef SWRITE_KF
#undef SWRITE_VF
#undef KPTR
#undef VPTR
#undef SBAR
}

struct Args { const float* in[22]; float* out; unsigned char* ws; int ph_lo, ph_hi; };
enum { I_XP = 0, I_XS, I_CP, I_CS, I_CK, I_CV, I_CLF, I_SCONV, I_WADA, I_BADA, I_NORMG, I_WIN, I_BF, I_QG, I_KG, I_CONVW, I_CONVB, I_LNG, I_LNB, I_WOA, I_WOB, I_WOUT };

__device__ __forceinline__ int srccol(int n) {
    const int tile = n >> 8, r = n & 255;
    if (tile < 12) return n;
    if (tile < 16) return 3080 + (n - 3072);
    if (tile < 24) { const int j = tile - 16; return r < 128 ? 4104 + 128 * j + r : 5128 + 128 * j + (r - 128); }
    if (tile < 28) return 6152 + (n - 6144);
    if (tile < 36) return 7176 + (n - 7168);
    return 9224 + (n - 9216);
}
__device__ __forceinline__ void transpose_item(const float* W, int ldw, int k0, int ns0, bf16_t* WT, int ldt, int nd0, int kd0, LAS float* scr, int lane) {
#pragma unroll 8
    for (int i = 0; i < 32; ++i) { const int kk = 2 * i + (lane >> 5); scr[kk * 33 + (lane & 31)] = W[(size_t)(k0 + kk) * ldw + ns0 + (lane & 31)]; }
    asm volatile("s_waitcnt lgkmcnt(0)" ::: "memory");
    const int c = lane & 7;
#pragma unroll
    for (int j = 0; j < 4; ++j) { const int n = (lane >> 3) + 8 * j; const LAS float* s = scr + (8 * c) * 33 + n;
        u32x4 o; o.x = cvtpk(s[0 * 33], s[1 * 33]); o.y = cvtpk(s[2 * 33], s[3 * 33]); o.z = cvtpk(s[4 * 33], s[5 * 33]); o.w = cvtpk(s[6 * 33], s[7 * 33]);
        *(u32x4*)(WT + (size_t)(nd0 + n) * ldt + kd0 + 8 * c) = o; }
    asm volatile("s_waitcnt lgkmcnt(0)" ::: "memory");
}

__device__ __forceinline__ void p0_prologue(const Args& A, LAS unsigned char* lds, int wg, int G) {
    const int tid = opaque_tid(), lane = tid & 63, wave = __builtin_amdgcn_readfirstlane(tid >> 6);
    unsigned char* ws = A.ws;
    {
        LAS float* sc = (LAS float*)lds;
        LAS float* red = (LAS float*)(lds + 81920);
        float* mod = (float*)(ws + WS_MOD);
        for (int u = wg; u < 2 * 96; u += G) {
            const int l = u / 96, cb = u % 96, col = cb * 64 + lane;
            const float* W = A.in[I_WADA] + (size_t)l * DM * 6144;
            float acc[NSEQ];
#pragma unroll
            for (int s = 0; s < NSEQ; ++s) acc[s] = 0.f;
            for (int half = 0; half < 2; ++half) {
                __syncthreads();
                for (int e = tid; e < 1024 * NSEQ; e += NTHR) { const int kk = e / NSEQ, s = e % NSEQ; const int k = half * 1024 + kk;
                    const float c = s < NB ? A.in[I_CP][s * DM + k] : A.in[I_CS][(s - NB) * DM + k];
                    sc[e] = c * fsigmoid(c); }
                __syncthreads();
                const int kb = wave * 128;
#pragma unroll 4
                for (int kk = 0; kk < 128; ++kk) {
                    const float w = W[(size_t)(half * 1024 + kb + kk) * 6144 + col];
                    const LAS f32x4* s4 = (const LAS f32x4*)(sc + (kb + kk) * NSEQ);
#pragma unroll
                    for (int q = 0; q < 5; ++q) { const f32x4 v = s4[q]; acc[4 * q] += w * v[0]; acc[4 * q + 1] += w * v[1]; acc[4 * q + 2] += w * v[2]; acc[4 * q + 3] += w * v[3]; }
                }
            }
#pragma unroll
            for (int s = 0; s < NSEQ; ++s) red[(wave * NSEQ + s) * 64 + lane] = acc[s];
            __syncthreads();
            for (int e = tid; e < NSEQ * 64; e += NTHR) { const int s = e >> 6, c = e & 63; float t = 0.f;
#pragma unroll
                for (int w = 0; w < 8; ++w) t += red[(w * NSEQ + s) * 64 + c];
                mod[((size_t)l * NSEQ + s) * 6144 + cb * 64 + c] = t + A.in[I_BADA][l * 6144 + cb * 64 + c]; }
            __syncthreads();
        }
    }
    const int gw = wg * NWAVES + wave, NGW = G * NWAVES;
    {
        float* FC = (float*)(ws + WS_FC);
        for (int u = gw; u < DEPTH * DB * NH; u += NGW) {
            const int h = u % NH, lb = u / NH; const float* src = A.in[I_CLF] + (size_t)lb * PAST * NH + h; float* dst = FC + (size_t)u * PAST;
            float carry = 0.f;
            for (int j = 0; j < PAST / 64; ++j) {
                float v = src[(size_t)(j * 64 + lane) * NH];
#pragma unroll
                for (int o = 1; o < 64; o <<= 1) { const float t = __shfl_up(v, o); if (lane >= o) v += t; }
                v += carry; dst[j * 64 + lane] = v; carry = __shfl(v, 63);
            }
        }
    }
    {
        float* WF = (float*)(ws + WS_WF);
        for (int e = wg * NTHR + tid; e < DEPTH * NH * DM; e += G * NTHR) { const int k = e % DM, h = (e / DM) % NH, l = e / (DM * NH);
            WF[e] = A.in[I_WIN][((size_t)l * DM + k) * DIN + 3072 + h]; }
    }
    {
        __syncthreads();
        LAS float* scr = (LAS float*)(lds + wave * 16384);
        constexpr int I_IN = (NIN / 32) * (DM / 64), I_OA = (DM / 32) * (DA / 64), I_OUT = (DM / 32) * (DM / 64), PER_L = I_IN + 2 * I_OA + I_OUT;
        for (int it = gw; it < DEPTH * PER_L; it += NGW) {
            const int l = it / PER_L; int r = it % PER_L;
            if (r < I_IN) { const int nb = r % (NIN / 32), kb = r / (NIN / 32);
                transpose_item(A.in[I_WIN] + (size_t)l * DM * DIN, DIN, kb * 64, srccol(nb * 32), (bf16_t*)(ws + WS_WIN) + (size_t)l * NIN * DM, DM, nb * 32, kb * 64, scr, lane); continue; }
            r -= I_IN;
            if (r < 2 * I_OA) { const int which = r / I_OA; r %= I_OA; const int nb = r % (DM / 32), kb = r / (DM / 32);
                transpose_item(A.in[which ? I_WOB : I_WOA] + (size_t)l * DA * DM, DM, kb * 64, nb * 32, (bf16_t*)(ws + WS_WOAB) + (size_t)l * DM * DM, DM, nb * 32, which * 1024 + kb * 64, scr, lane); continue; }
            r -= 2 * I_OA;
            { const int nb = r % (DM / 32), kb = r / (DM / 32);
                transpose_item(A.in[I_WOUT] + (size_t)l * DM * DM, DM, kb * 64, nb * 32, (bf16_t*)(ws + WS_WOUT) + (size_t)l * DM * DM, DM, nb * 32, kb * 64, scr, lane); }
        }
    }
}

__device__ __forceinline__ void p1_norm(const Args& A, int l, LAS unsigned char* lds, int wg, int G) {
    const int tid = opaque_tid(), lane = tid & 63, wave = __builtin_amdgcn_readfirstlane(tid >> 6);
    unsigned char* ws = A.ws;
    LAS float* wf = (LAS float*)lds;
    LAS float* gs = (LAS float*)(lds + 65536);
    LAS float* sh = (LAS float*)(lds + 65536 + 8192);
    const float* WF = (const float*)(ws + WS_WF) + (size_t)l * NH * DM;
    const float* mod = (const float*)(ws + WS_MOD) + (size_t)l * NSEQ * 6144;
    bf16_t* H = (bf16_t*)(ws + WS_H);
    for (int e = tid; e < NH * DM / 4; e += NTHR) ((LAS f32x4*)wf)[e] = ((const f32x4*)WF)[e];
    const float* xp = l == 0 ? A.in[I_XP] : A.out + O_YP; const float* xs = l == 0 ? A.in[I_XS] : A.out + O_YS;
    float bfv = 0.f; if (lane < NH) bfv = A.in[I_BF][l * NH + lane];
    int cur_s = -1;
    for (int u = wg; u < MT / 32; u += G) {
        const int row0 = u * 32, s = seq_of_row(row0);
        if (s != cur_s) {
            __syncthreads();
            for (int e = tid; e < DM; e += NTHR) { gs[e] = A.in[I_NORMG][l * DM + e] * (1.0f + mod[(size_t)s * 6144 + DM + e]); sh[e] = mod[(size_t)s * 6144 + e]; }
            cur_s = s;
        }
        __syncthreads();
#pragma unroll 1
        for (int rr = 0; rr < 4; ++rr) {
            const int row = row0 + wave * 4 + rr;
            const float* xrow = row < MP ? xp + (size_t)row * DM : xs + (size_t)(row - MP) * DM;
            const f32x4* xr = (const f32x4*)xrow + lane;
            f32x4 v[8]; float ss = 0.f;
#pragma unroll
            for (int j = 0; j < 8; ++j) { v[j] = xr[64 * j]; ss += (v[j][0] * v[j][0] + v[j][1] * v[j][1]) + (v[j][2] * v[j][2] + v[j][3] * v[j][3]); }
            const float rstd = __builtin_amdgcn_rsqf(wave_sum(ss) * (1.0f / DM) + EPS);
            u32x2* ho = (u32x2*)(H + (size_t)row * DM) + lane;
#pragma unroll
            for (int j = 0; j < 8; ++j) { const f32x4 g4 = ((const LAS f32x4*)gs)[lane + 64 * j], s4 = ((const LAS f32x4*)sh)[lane + 64 * j];
                v[j] = v[j] * rstd * g4 + s4; u32x2 w; w.x = cvtpk(v[j][0], v[j][1]); w.y = cvtpk(v[j][2], v[j][3]); ho[64 * j] = w; }
            float fl[NH];
#pragma unroll
            for (int h = 0; h < NH; ++h) { float a = 0.f;
#pragma unroll
                for (int j = 0; j < 8; ++j) { const f32x4 w4 = ((const LAS f32x4*)(wf + h * DM))[lane + 64 * j]; a += (v[j][0] * w4[0] + v[j][1] * w4[1]) + (v[j][2] * w4[2] + v[j][3] * w4[3]); }
                fl[h] = wave_sum(a); }
            float mine = 0.f;
#pragma unroll
            for (int h = 0; h < NH; ++h) mine = lane == h ? fl[h] : mine;
            if (lane < NH) { const float z = mine + bfv; const float lf = fminf(z, 0.f) - log1pf(__expf(-fabsf(z)));
                float* o = row < MP ? A.out + O_FP + ((size_t)l * MP + row) * NH : A.out + O_FS + ((size_t)l * MS + (row - MP)) * NH; o[lane] = lf; }
        }
    }
}

__device__ __forceinline__ void fill_bias_prompt(char* lds, const float* logf  , int nkeys) {
    const int tid = opaque_tid(), lane = tid & 63, wave = tid >> 6;
    float* cb = (float*)(lds + fa::OFF_BIAS); float* red = (float*)(lds + fa::OFF_RED);
    float v[4]; float run = 0.f;
#pragma unroll
    for (int j = 0; j < 4; ++j) { const int k = 4 * tid + j; const float x = k < nkeys ? logf[(size_t)k * NH] : 0.f; run += x; v[j] = run; }
    float incl = run;
#pragma unroll
    for (int o = 1; o < 64; o <<= 1) { const float t = __shfl_up(incl, o); if (lane >= o) incl += t; }
    if (lane == 63) red[wave] = incl;
    __syncthreads();
    float off = incl - run;
    for (int w = 0; w < wave; ++w) off += red[w];
#pragma unroll
    for (int j = 0; j < 4; ++j) { const int k = 4 * tid + j; if (k < nkeys) cb[k] = -(off + v[j]) * fa::INV_SCALE; }
    __syncthreads();
}
__device__ __forceinline__ void fill_bias_sample(char* lds, const float* FCrow, const float* logf_new  ) {
    const int tid = opaque_tid(), lane = tid & 63;
    float* cb = (float*)(lds + fa::OFF_BIAS);
    for (int k = tid; k < PAST; k += NTHR) cb[k] = -FCrow[k] * fa::INV_SCALE;
    if (tid < 64) { float v = logf_new[(size_t)lane * NH];
#pragma unroll
        for (int o = 1; o < 64; o <<= 1) { const float t = __shfl_up(v, o); if (lane >= o) v += t; }
        cb[PAST + lane] = -(FCrow[PAST - 1] + v) * fa::INV_SCALE; }
    __syncthreads();
}
__device__ __forceinline__ void conv_unit(const Args& A, int l, char* lds, int u) {
    const int tid = opaque_tid(), lane = tid & 63, wave = __builtin_amdgcn_readfirstlane(tid >> 6);
    unsigned char* ws = A.ws;
    const bf16_t* U = (const bf16_t*)(ws + WS_U); const bf16_t* GB = (const bf16_t*)(ws + WS_GB); bf16_t* YAB = (bf16_t*)(ws + WS_YAB);
    int s, t0, mrow0; bool prompt = u < 512;
    if (prompt) { s = u >> 7; t0 = (u & 127) * 16; mrow0 = s * SEQ; } else { const int v = u - 512; s = v >> 2; t0 = (v & 3) * 16; mrow0 = MP + s * DS; }
    bf16_t* ut = (bf16_t*)lds;
    float* cv = (float*)(lds + 46 * 2048);
    __syncthreads();
    for (int e = tid; e < 46 * 128; e += NTHR) { const int r = e >> 7, c8 = (e & 127) * 8, t = t0 - 30 + r;
        u32x4 w = {0u, 0u, 0u, 0u};
        if (t >= 0) w = *(const u32x4*)(U + (size_t)(mrow0 + t) * DC + c8);
        else if (!prompt) { const float* sp = A.in[I_SCONV] + (((size_t)l * DB + s) * 30 + (30 + t)) * DC + c8; w = pack8f(*(const f32x4*)sp, *(const f32x4*)(sp + 4)); }
        *(u32x4*)(ut + r * 1024 + c8) = w; }
    float w0[CW], w1[CW];
    const float* cw = A.in[I_CONVW] + (size_t)l * CW * DC + 2 * tid;
#pragma unroll
    for (int j = 0; j < CW; ++j) { const f32x2v w = *(const f32x2v*)(cw + (size_t)j * DC); w0[j] = w[0]; w1[j] = w[1]; }
    const f32x2v cbv = *(const f32x2v*)(A.in[I_CONVB] + l * DC + 2 * tid);
    __syncthreads();
#pragma unroll 1
    for (int sub = 0; sub < 2; ++sub) {
#pragma unroll 1
        for (int tt = 0; tt < 8; ++tt) {
            const int r0 = sub * 8 + tt; float a0 = cbv[0], a1 = cbv[1];
            const unsigned* up = (const unsigned*)(ut + r0 * 1024) + tid;
#pragma unroll
            for (int j = 0; j < CW; ++j) { const unsigned x = up[j * 512]; a0 += w0[j] * bf_lo(x); a1 += w1[j] * bf_hi(x); }
            *(f32x2v*)(cv + tt * 1024 + 2 * tid) = (f32x2v){a0, a1};
        }
        __syncthreads();
        {
            const int t = t0 + sub * 8 + wave; const size_t m = (size_t)mrow0 + t;
            const f32x4* c4 = (const f32x4*)(cv + wave * 1024) + lane;
            f32x4 x[4]; float sum = 0.f;
#pragma unroll
            for (int j = 0; j < 4; ++j) { x[j] = c4[64 * j]; sum += (x[j][0] + x[j][1]) + (x[j][2] + x[j][3]); }
            const float mean = wave_sum(sum) * (1.0f / DC); float sq = 0.f;
#pragma unroll
            for (int j = 0; j < 4; ++j) { x[j] = x[j] - mean; sq += (x[j][0] * x[j][0] + x[j][1] * x[j][1]) + (x[j][2] * x[j][2] + x[j][3] * x[j][3]); }
            const float rstd = __builtin_amdgcn_rsqf(wave_sum(sq) * (1.0f / DC) + EPS);
#pragma unroll
            for (int j = 0; j < 4; ++j) { const int c = 4 * lane + 256 * j;
                const f32x4 g4 = *(const f32x4*)(A.in[I_LNG] + l * DC + c), b4 = *(const f32x4*)(A.in[I_LNB] + l * DC + c);
                const u32x2 gb = *(const u32x2*)(GB + m * DC + c);
                f32x4 y = x[j] * rstd * g4 + b4;
#pragma unroll
                for (int i = 0; i < 4; ++i) y[i] *= fsigmoid(y[i]);
                y[0] *= bf_lo(gb.x); y[1] *= bf_hi(gb.x); y[2] *= bf_lo(gb.y); y[3] *= bf_hi(gb.y);
                u32x2 o; o.x = cvtpk(y[0], y[1]); o.y = cvtpk(y[2], y[3]);
                *(u32x2*)(YAB + m * 2048 + 1024 + c) = o; }
        }
        __syncthreads();
    }
}
__device__ __forceinline__ void p3_mix(const Args& A, int l, char* lds, int wg, int G) {
    unsigned char* ws = A.ws;
    const bf16_t* Q = (const bf16_t*)(ws + WS_Q); const bf16_t* Kb = (const bf16_t*)(ws + WS_K); const bf16_t* Vb = (const bf16_t*)(ws + WS_V);
    const bf16_t* GA = (const bf16_t*)(ws + WS_GA); bf16_t* YAB = (bf16_t*)(ws + WS_YAB);
    const int GP = G / 2 > 0 ? G / 2 : 1;
#ifndef P3M
#define P3M 7
#endif
    if ((P3M & 1) && (wg < GP || G == 1)) {
        for (int it = wg; it < NB * NH * 4; it += GP) {
            const int bh = it >> 2, x = it & 3, b = bh >> 3, h = bh & 7;
            __syncthreads();
            fill_bias_prompt(lds, A.out + O_FP + ((size_t)l * MP + (size_t)b * SEQ) * NH + h, (8 - x) * 256);
            const size_t base = (size_t)b * SEQ * 1024 + h * 128;
            fa::BlockRef<bf16_t> r0, r1;
            r0.K = Kb + base; r0.V = Vb + base; r0.K2 = r0.K; r0.V2 = r0.V; r0.nk1 = 1 << 30; r0.live = 256;
            r1 = r0;
            r0.P0 = x * 256; r0.Q = Q + base + (size_t)r0.P0 * 1024; r0.G = GA + base + (size_t)r0.P0 * 1024; r0.O = YAB + ((size_t)b * SEQ + r0.P0) * 2048 + h * 128;
            r1.P0 = (7 - x) * 256; r1.Q = Q + base + (size_t)r1.P0 * 1024; r1.G = GA + base + (size_t)r1.P0 * 1024; r1.O = YAB + ((size_t)b * SEQ + r1.P0) * 2048 + h * 128;
            fa::Seam S;
            fa::attn_prime<bf16_t>(r0, lds, S);
#pragma unroll 1
            for (int pass = 0; pass < 2; ++pass) fa::attn_block<bf16_t>(pass ? r1 : r0, r1, SEQ, lds, S);
        }
    }
    if ((P3M & 2) && (wg >= GP || G == 1)) {
        const int w2 = G == 1 ? 0 : wg - GP, G2 = G == 1 ? 1 : G - GP;
        for (int it = w2; it < DB * NH; it += G2) {
            const int b = it >> 3, h = it & 7;
            __syncthreads();
            fill_bias_sample(lds, (const float*)(ws + WS_FC) + (((size_t)l * DB + b) * NH + h) * PAST, A.out + O_FS + ((size_t)l * MS + (size_t)b * DS) * NH + h);
            fa::BlockRef<float> r;
            const size_t cbase = (((size_t)l * DB + b) * PAST) * 1024 + h * 128, nbase = ((size_t)l * MS + (size_t)b * DS) * 1024 + h * 128;
            r.K = A.in[I_CK] + cbase; r.V = A.in[I_CV] + cbase; r.K2 = A.out + O_KS + nbase; r.V2 = A.out + O_VS + nbase; r.nk1 = PAST;
            const size_t qb = ((size_t)MP + (size_t)b * DS) * 1024 + h * 128;
            r.Q = Q + qb; r.G = GA + qb; r.O = YAB + ((size_t)MP + (size_t)b * DS) * 2048 + h * 128; r.P0 = PAST; r.live = DS;
            fa::Seam S;
            fa::attn_prime<float>(r, lds, S);
            fa::attn_block<float>(r, r, PAST + DS, lds, S);
        }
    }
    if ((P3M & 4) && (wg < GP || G == 1)) { for (int u = wg; u < 576; u += GP) conv_unit(A, l, lds, u); }
}

constexpr int N_PHASES = 1 + 5 * DEPTH;
__global__ void __launch_bounds__(NTHR, 2) fox_fwd(Args args) {
    extern __shared__ __attribute__((aligned(16))) unsigned char lds[];
    LAS unsigned char* L = (LAS unsigned char*)lds;
    volatile LAS unsigned* MISC = (volatile LAS unsigned*)(L + MISC_OFF);
    const int tid = threadIdx.x;
    const int G = gridDim.x, wg = blockIdx.x;
    if (tid < 32) MISC[tid] = 0u;
    __syncthreads();
    unsigned char* ws = args.ws;
    unsigned* ctl = (unsigned*)(ws + WS_CTL);
    const int lo = args.ph_lo, hi = args.ph_hi;
    XcdBarrier bar; bar.bar = ctl + CW_BAR; bar.x = 0; bar.st = nullptr;
    if (hi - lo > 1) bar = xcd_barrier_post(ctl + CW_BAR, MISC + 8);
#define IN(k) (lo <= (k) && (k) < hi)
#define SEAM(k) do { if (IN((k) + 1)) xcd_barrier(bar); } while (0)
#ifndef PHM
#define PHM 63
#endif
    if ((PHM & 1) && IN(0)) { p0_prologue(args, L, wg, G); SEAM(0); }
    for (int l = 0; l < DEPTH; ++l) {
        const int pb = 1 + 5 * l;
        if ((PHM & 2) && IN(pb + 0)) { p1_norm(args, l, L, wg, G); SEAM(pb + 0); }
        if ((PHM & 4) && IN(pb + 1)) {
            pg8::Gemm g{(const bf16_t*)(ws + WS_H), (const bf16_t*)(ws + WS_WIN) + (size_t)l * NIN * DM, MT, NIN, DM};
            pg8::StaticOrder S; S.init(MT, NIN, G, wg);
            EpiIn E{ws, args.out, l, args.in[I_QG] + l * HD, args.in[I_KG] + l * HD, (LAS float*)(L + XS_OFF)};
            pg8::gemm_phase<EpiIn, pg8::StaticOrder, true, true>(L, g, S, E);
            SEAM(pb + 1);
        }
        if ((PHM & 8) && IN(pb + 2)) { p3_mix(args, l, (char*)lds, wg, G); SEAM(pb + 2); }
        if ((PHM & 16) && IN(pb + 3)) {
            pg8::Gemm g{(const bf16_t*)(ws + WS_YAB), (const bf16_t*)(ws + WS_WOAB) + (size_t)l * DM * DM, MT, DM, DM};
            pg8::StaticOrder S; S.init(MT, DM, G, wg);
            EpiMerge E{(const bf16_t*)(ws + WS_SA), (const bf16_t*)(ws + WS_SB), (bf16_t*)(ws + WS_H)};
            pg8::gemm_phase<EpiMerge, pg8::StaticOrder, true, true>(L, g, S, E);
            SEAM(pb + 3);
        }
        if ((PHM & 32) && IN(pb + 4)) {
            pg8::Gemm g{(const bf16_t*)(ws + WS_H), (const bf16_t*)(ws + WS_WOUT) + (size_t)l * DM * DM, MT, DM, DM};
            pg8::StaticOrder S; S.init(MT, DM, G, wg);
            EpiOut E{l == 0 ? args.in[I_XP] : args.out + O_YP, l == 0 ? args.in[I_XS] : args.out + O_YS, args.out, (const float*)(ws + WS_MOD) + (size_t)l * NSEQ * 6144 + 2 * DM};
            pg8::gemm_phase<EpiOut, pg8::StaticOrder, true, true>(L, g, S, E);
            SEAM(pb + 4);
        }
    }
#undef IN
#undef SEAM
}

extern "C" void kernel_launch(void* const* d_in, const int* in_sizes, int n_in, void* d_out, int out_size, void* d_ws, size_t ws_size, hipStream_t stream) {
    static int grid = 0;
    if (grid == 0) {
        if (n_in != 22 || out_size != (int)O_END || ws_size < WS_END) { fprintf(stderr, "kernel_launch: unexpected shapes (n_in %d, out %d, ws %zu)\n", n_in, out_size, ws_size); grid = -1; return; }
        int dev = 0, cus = 0, per_cu = 0;
        if (hipGetDevice(&dev) != hipSuccess || hipDeviceGetAttribute(&cus, hipDeviceAttributeMultiprocessorCount, dev) != hipSuccess) { grid = -1; return; }
        if (hipFuncSetAttribute((const void*)fox_fwd, hipFuncAttributeMaxDynamicSharedMemorySize, LDS_BYTES) != hipSuccess) { fprintf(stderr, "kernel_launch: hipFuncSetAttribute failed\n"); grid = -1; return; }
        if (hipOccupancyMaxActiveBlocksPerMultiprocessor(&per_cu, (const void*)fox_fwd, NTHR, LDS_BYTES) != hipSuccess || per_cu < 1) { fprintf(stderr, "kernel_launch: occupancy query says %d\n", per_cu); (void)hipGetLastError(); }
        grid = cus;
    }
    if (grid < 0) return;
    (void)hipMemsetAsync((char*)d_ws + WS_CTL, 0, CTL_ZERO_BYTES, stream);
    Args a{};
    for (int i = 0; i < 22; ++i) a.in[i] = (const float*)d_in[i];
    a.out = (float*)d_out; a.ws = (unsigned char*)d_ws;
#if MK_ONE_LAUNCH
    a.ph_lo = 0; a.ph_hi = N_PHASES;
    hipLaunchKernelGGL(fox_fwd, dim3(grid), dim3(NTHR), LDS_BYTES, stream, a);
#else
    for (int p = 0; p < N_PHASES; ++p) { a.ph_lo = p; a.ph_hi = p + 1; hipLaunchKernelGGL(fox_fwd, dim3(grid), dim3(NTHR), LDS_BYTES, stream, a); }
#endif
}
```

```cpp
#include <hip/hip_runtime.h>
#include <cstdio>
#include <cstdint>
#ifndef MK_ONE_LAUNCH
#define MK_ONE_LAUNCH 1
#endif
__device__ __forceinline__ int opaque_tid() { int t = threadIdx.x; asm volatile("" : "+v"(t)); return t; }
#ifdef NO_LAUNDER_S
template <class T> __device__ __forceinline__ T* opaque_p(T* p) { return p; }
__device__ __forceinline__ int opaque_s(int v) { return v; }
#else
template <class T> __device__ __forceinline__ T* opaque_p(T* p) { __attribute__((address_space(1))) T* q = (__attribute__((address_space(1))) T*)p; asm volatile("" : "+s"(q)); return (T*)q; }
__device__ __forceinline__ int opaque_s(int v) { asm volatile("" : "+s"(v)); return v; }
#endif
namespace pg8 {
#define PG8_LAS __attribute__((address_space(3)))
typedef unsigned short bf16_t;
typedef short bf16x8 __attribute__((ext_vector_type(8)));
typedef float f32x4 __attribute__((ext_vector_type(4)));
typedef unsigned u32x4 __attribute__((ext_vector_type(4)));
constexpr int BM = 256, BK = 64, HALF = 128, HTB = HALF * BK * 2  , STAGE_BYTES = 8 * HTB, NXCD = 8, WGM = 8;

__host__ __device__ __forceinline__ int lds_byte(int r, int c) { const int st = (r >> 4) * 2 + (c >> 5), rr = r & 15, cc = c & 31, ob = rr * 64 + cc * 2; return st * 1024 + (ob ^ (((ob >> 9) & 1) << 5)); }
__host__ __device__ __forceinline__ void stage_rc(int b, int& R, int& C) { const int st = b / 1024, sb = b % 1024, swz = sb ^ (((sb >> 9) & 1) << 5); R = (st >> 1) * 16 + swz / 64; C = (st & 1) * 32 + (swz % 64) / 2; }
__host__ __device__ __forceinline__ int perm32(int rho) { const int n = rho >> 4, i = rho & 15; return 8 * (i >> 2) + 4 * n + (i & 3); }

struct Unit { int pm, pn; };
struct Gemm { const bf16_t* A; const bf16_t* Bt; int M, N, K; };

struct StaticOrder {
    int nM, nN, nwg, G, c;
    __host__ __device__ void init(int M, int N, int G_, int c_) { nM = M / BM; nN = N / BM; nwg = nM * nN; G = G_; c = c_; }
    __host__ __device__ bool next(int i, Unit& u) const {
        const long L = (long)i * G + c; if (L >= nwg) return false;
        int wgid = (int)L; { const int q = nwg / NXCD, r = nwg % NXCD, xcd = wgid % NXCD, off = wgid / NXCD; wgid = (xcd < r ? xcd * (q + 1) : r * (q + 1) + (xcd - r) * q) + off; }
        const int nig = WGM * nN, gid = wgid / nig, fm = gid * WGM, gsz = (nM - fm) < WGM ? (nM - fm) : WGM;
        u.pm = fm + ((wgid % nig) % gsz); u.pn = (wgid % nig) / gsz; return true;
    }
    __device__ __forceinline__ void a_ready(const Unit&) const {}
    __device__ __forceinline__ void done(const Unit&) const {}
};

__device__ __forceinline__ unsigned cvt_pk_bf16(float lo, float hi) { unsigned r; asm volatile("v_cvt_pk_bf16_f32 %0, %1, %2" : "=v"(r) : "v"(lo), "v"(hi)); return r; }
typedef float f32x2 __attribute__((ext_vector_type(2)));
template <class Epi, class Sched, bool ALIGN_EPI = false, bool SP2 = false>
__device__ __forceinline__ void gemm_phase(PG8_LAS unsigned char* lds, const Gemm g, const Sched& S, const Epi& E) {
    const int tid = opaque_tid(), wid = __builtin_amdgcn_readfirstlane(tid >> 6), lane = tid & 63, wr = wid >> 2, wc = wid & 3, fr = lane & 15, fq = lane >> 4;
    const int K = g.K, nt = K / BK;
    unsigned voffA[2], voffB[2];
#pragma unroll
    for (int i = 0; i < 2; ++i) { int R, C; stage_rc(tid * 16 + i * 8192, R, C); const int Rb = Epi::PERM ? ((R & ~31) + perm32(R & 31)) : R;
        voffA[i] = (unsigned)(R * K + C) * 2u; voffB[i] = (unsigned)(Rb * K + C) * 2u; }
    const size_t kstep = (size_t)(BK * 2);
    const size_t hstep = (size_t)HALF * K * 2;
    const size_t tstep = 2 * hstep;
    const unsigned ldsw = (unsigned)wid * 1024u;
    const int aoff = lds_byte(wr * 64 + fr, fq * 8), boff = lds_byte(wc * 32 + fr, fq * 8);
#define PG8_SA(b, h) (((b) * 2 + (h)) * HTB)
#define PG8_SB(b, h) ((4 + (b) * 2 + (h)) * HTB)
#define PG8_STAGE(bufoff, gbase, voff) do { _Pragma("unroll") for (int _i = 0; _i < 2; ++_i) \
        __builtin_amdgcn_global_load_lds((const unsigned*)((const char*)(gbase) + (voff)[_i]), (PG8_LAS unsigned*)(lds + (bufoff) + ldsw + _i * 8192), 16, 0, 0); } while (0)
#define PG8_LDA(dst, b, h) do { _Pragma("unroll") for (int m = 0; m < 4; ++m) _Pragma("unroll") for (int k = 0; k < 2; ++k) dst[m][k] = *(const PG8_LAS bf16x8*)(lds + PG8_SA(b, h) + aoff + m * 2048 + k * 1024); } while (0)
#define PG8_LDB(dst, b, h) do { _Pragma("unroll") for (int n = 0; n < 2; ++n) _Pragma("unroll") for (int k = 0; k < 2; ++k) dst[n][k] = *(const PG8_LAS bf16x8*)(lds + PG8_SB(b, h) + boff + n * 2048 + k * 1024); } while (0)
#define PG8_MMA(ai, bj, At, Bt) do { __builtin_amdgcn_s_setprio(1); _Pragma("unroll") for (int m = 0; m < 4; ++m) _Pragma("unroll") for (int n = 0; n < 2; ++n) _Pragma("unroll") for (int k = 0; k < 2; ++k) \
        acc[ai][bj][m][n] = __builtin_amdgcn_mfma_f32_16x16x32_bf16(Bt[n][k], At[m][k], acc[ai][bj][m][n], 0, 0, 0); __builtin_amdgcn_s_setprio(0); } while (0)
#define PG8_WAIT_V(n) asm volatile("s_waitcnt vmcnt(" #n ")" ::: "memory")
#define PG8_WAIT_L(n) asm volatile("s_waitcnt lgkmcnt(" #n ")" ::: "memory")
#define PG8_BAR __builtin_amdgcn_s_barrier()
#define PG8_SCHED __builtin_amdgcn_sched_barrier(0)
    Unit cur, nxt; int ui = 0;
    if (!S.next(0, cur)) return;
    f32x4 acc[2][2][4][2];
#pragma unroll
    for (int a = 0; a < 2; ++a)
#pragma unroll
        for (int b = 0; b < 2; ++b)
#pragma unroll
            for (int m = 0; m < 4; ++m)
#pragma unroll
                for (int n = 0; n < 2; ++n) acc[a][b][m][n] = (f32x4){0.f, 0.f, 0.f, 0.f};
    bf16x8 At[4][2], B0[2][2], B1[2][2];
    const char* cA = (const char*)g.A + (size_t)cur.pm * tstep; const char* cB = (const char*)g.Bt + (size_t)cur.pn * tstep;
    S.a_ready(cur);
    if constexpr (SP2) {
        PG8_STAGE(PG8_SB(0, 0), cB, voffB); PG8_STAGE(PG8_SB(0, 1), cB + hstep, voffB); PG8_STAGE(PG8_SA(0, 0), cA, voffA); PG8_STAGE(PG8_SA(0, 1), cA + hstep, voffA);
        if (wr == 1) PG8_BAR;
        PG8_WAIT_V(2); PG8_BAR;
        PG8_STAGE(PG8_SB(1, 0), cB + kstep, voffB); PG8_STAGE(PG8_SA(1, 0), cA + kstep, voffA); PG8_STAGE(PG8_SB(1, 1), cB + hstep + kstep, voffB);
        PG8_WAIT_V(6); PG8_BAR;
    } else {
        PG8_STAGE(PG8_SB(0, 0), cB, voffB); PG8_STAGE(PG8_SA(0, 0), cA, voffA); PG8_STAGE(PG8_SB(0, 1), cB + hstep, voffB); PG8_STAGE(PG8_SA(0, 1), cA + hstep, voffA);
        if (wr == 1) PG8_BAR;
        PG8_WAIT_V(4); PG8_BAR;
        PG8_STAGE(PG8_SB(1, 0), cB + kstep, voffB); PG8_STAGE(PG8_SA(1, 0), cA + kstep, voffA); PG8_STAGE(PG8_SB(1, 1), cB + hstep + kstep, voffB);
        PG8_WAIT_V(6); PG8_BAR;
    }
    for (;;) {
        const bool has_next = S.next(ui + 1, nxt);
        const char* nA = has_next ? (const char*)g.A + (size_t)nxt.pm * tstep : cA; const char* nB = has_next ? (const char*)g.Bt + (size_t)nxt.pn * tstep : cB;
        for (int t = 0; t < nt; t += 2) {
            if constexpr (Epi::HAS_MID) { if (t == (nt >> 1)) { E.mid(acc, cur, wr, wc, fr, fq); PG8_SCHED; } }
            const bool last = (t == nt - 2);
            const char* a1 = cA + (size_t)(t + 1) * kstep;
            const char* a2 = last ? nA : cA + (size_t)(t + 2) * kstep; const char* b2 = last ? nB : cB + (size_t)(t + 2) * kstep;
            const char* a3 = a2 + kstep; const char* b3 = b2 + kstep;
            if (last && has_next) S.a_ready(nxt);
            if constexpr (SP2) {
            PG8_LDB(B0, 0, 0); PG8_LDB(B1, 0, 1); PG8_SCHED; PG8_LDA(At, 0, 0); PG8_STAGE(PG8_SA(1, 1), a1 + hstep, voffA);
            PG8_WAIT_V(8); PG8_WAIT_L(0); PG8_BAR; PG8_MMA(0, 0, At, B0); PG8_MMA(0, 1, At, B1); PG8_BAR; PG8_SCHED;
            PG8_LDA(At, 0, 1); PG8_STAGE(PG8_SB(0, 0), b2, voffB); PG8_STAGE(PG8_SB(0, 1), b2 + hstep, voffB); PG8_STAGE(PG8_SA(0, 0), a2, voffA);
            PG8_WAIT_V(8); PG8_WAIT_L(0); PG8_BAR; PG8_MMA(1, 0, At, B0); PG8_MMA(1, 1, At, B1); PG8_BAR; PG8_SCHED;
            PG8_LDB(B0, 1, 0); PG8_LDB(B1, 1, 1); PG8_SCHED; PG8_LDA(At, 1, 0); PG8_STAGE(PG8_SA(0, 1), a2 + hstep, voffA);
            PG8_WAIT_V(8); PG8_WAIT_L(0); PG8_BAR; PG8_MMA(0, 0, At, B0); PG8_MMA(0, 1, At, B1); PG8_BAR; PG8_SCHED;
            PG8_LDA(At, 1, 1); PG8_STAGE(PG8_SB(1, 0), b3, voffB); PG8_STAGE(PG8_SB(1, 1), b3 + hstep, voffB); PG8_STAGE(PG8_SA(1, 0), a3, voffA);
            PG8_WAIT_V(8); PG8_WAIT_L(0); PG8_BAR; PG8_MMA(1, 0, At, B0); PG8_MMA(1, 1, At, B1); PG8_BAR; PG8_SCHED;
            } else {
            PG8_LDB(B0, 0, 0); PG8_SCHED; PG8_LDA(At, 0, 0); PG8_STAGE(PG8_SA(1, 1), a1 + hstep, voffA);
            PG8_WAIT_L(8); PG8_BAR; PG8_WAIT_L(0); PG8_MMA(0, 0, At, B0); PG8_BAR; PG8_SCHED;
            PG8_LDB(B1, 0, 1); PG8_STAGE(PG8_SB(0, 0), b2, voffB);
            PG8_BAR; PG8_WAIT_L(0); PG8_MMA(0, 1, At, B1); PG8_BAR;
            PG8_LDA(At, 0, 1); PG8_STAGE(PG8_SA(0, 0), a2, voffA);
            PG8_BAR; PG8_WAIT_L(0); PG8_MMA(1, 0, At, B0); PG8_BAR; PG8_SCHED;
            PG8_STAGE(PG8_SB(0, 1), b2 + hstep, voffB);
            PG8_WAIT_V(6); PG8_BAR; PG8_MMA(1, 1, At, B1); PG8_BAR;
            PG8_LDB(B0, 1, 0); PG8_SCHED; PG8_LDA(At, 1, 0); PG8_STAGE(PG8_SA(0, 1), a2 + hstep, voffA);
            PG8_WAIT_L(8); PG8_BAR; PG8_WAIT_L(0); PG8_MMA(0, 0, At, B0); PG8_BAR; PG8_SCHED;
            PG8_LDB(B1, 1, 1); PG8_STAGE(PG8_SB(1, 0), b3, voffB);
            PG8_BAR; PG8_WAIT_L(0); PG8_MMA(0, 1, At, B1); PG8_BAR;
            PG8_LDA(At, 1, 1); PG8_STAGE(PG8_SA(1, 0), a3, voffA);
            PG8_BAR; PG8_WAIT_L(0); PG8_MMA(1, 0, At, B0); PG8_BAR; PG8_SCHED;
            PG8_STAGE(PG8_SB(1, 1), b3 + hstep, voffB);
            PG8_WAIT_V(6); PG8_BAR; PG8_MMA(1, 1, At, B1); PG8_BAR;
            }
        }
        if constexpr (ALIGN_EPI) { if (wr == 0) PG8_BAR; }
        if constexpr (!Epi::AFTER_DRAIN) { E(acc, cur, wr, wc, fr, fq); S.done(cur); }
        if (!has_next) break;
#pragma unroll
        for (int a = 0; a < 2; ++a)
#pragma unroll
            for (int b = 0; b < 2; ++b)
#pragma unroll
                for (int m = 0; m < 4; ++m)
#pragma unroll
                    for (int n = 0; n < 2; ++n) acc[a][b][m][n] = (f32x4){0.f, 0.f, 0.f, 0.f};
        cur = nxt; cA = nA; cB = nB; ++ui;
        if constexpr (ALIGN_EPI) { if (wr == 1) PG8_BAR; }
    }
    PG8_WAIT_V(0);
    if constexpr (!ALIGN_EPI) { if (wr == 0) PG8_BAR; }
    PG8_BAR;
    if constexpr (Epi::AFTER_DRAIN) { E.fused(acc, cur, wr, wc, fr, fq, lds, wid, lane); S.done(cur); }
#undef PG8_SA
#undef PG8_SB
#undef PG8_STAGE
#undef PG8_LDA
#undef PG8_LDB
#undef PG8_MMA
#undef PG8_WAIT_V
#undef PG8_WAIT_L
#undef PG8_BAR
#undef PG8_SCHED
}
}

using pg8::bf16_t; using pg8::bf16x8; using pg8::f32x4; using pg8::u32x4; using pg8::Unit;
typedef float f32x16 __attribute__((ext_vector_type(16)));
typedef float f32x2v __attribute__((ext_vector_type(2)));
typedef short s16x4 __attribute__((ext_vector_type(4)));
typedef unsigned u32x2 __attribute__((ext_vector_type(2)));
#define LAS __attribute__((address_space(3)))
#define GAS __attribute__((address_space(1)))

constexpr int DM = 2048, NB = 4, SEQ = 2048, DEPTH = 2, DB = 16, DS = 64, PAST = 4096;
constexpr int NH = 8, HD = 128, DA = 1024, DC = 1024, CW = 31, DIN = 11272, NIN = 11264;
constexpr int MP = NB * SEQ, MS = DB * DS, MT = MP + MS, NSEQ = NB + DB;
constexpr float EPS = 1e-6f;
constexpr int NWAVES = 8, NTHR = 512;
constexpr size_t O_YP = 0, O_YS = 16777216, O_KP = 18874368, O_VP = 35651584, O_FP = 52428800, O_CP = 52559872,
                 O_KS = 52805632, O_VS = 54902784, O_FS = 56999936, O_CS = 57016320, O_END = 57999360;
constexpr size_t MiB = 1u << 20;
constexpr size_t WS_CTL = 0, CTL_ZERO_BYTES = 1 * MiB;
constexpr size_t WS_WF = 1 * MiB;
constexpr size_t WS_MOD = 2 * MiB;
constexpr size_t WS_FC = 4 * MiB;
constexpr size_t WS_WIN = 8 * MiB;
constexpr size_t WS_WOAB = 96 * MiB;
constexpr size_t WS_WOUT = 112 * MiB;
constexpr size_t WS_H = 128 * MiB;
constexpr size_t WS_Q = 164 * MiB, WS_K = 183 * MiB, WS_V = 202 * MiB;
constexpr size_t WS_GA = 221 * MiB, WS_U = 239 * MiB, WS_GB = 257 * MiB;
constexpr size_t WS_SA = 275 * MiB, WS_SB = 311 * MiB;
constexpr size_t WS_YAB = 347 * MiB;
constexpr size_t WS_PO = 383 * MiB;
constexpr size_t WS_PML = 391 * MiB;
constexpr size_t WS_END = 392 * MiB;
constexpr int CW_BAR = 4096;
constexpr int CW_Q3 = 8192;
constexpr int CW_Q0 = 8192 + 256;
constexpr int RING_BYTES = 131072;
constexpr int XS_OFF = RING_BYTES;
constexpr int LDS_BYTES = 163840;
constexpr int MISC_OFF = LDS_BYTES - 256;

__device__ __forceinline__ float wave_sum(float v) {
#pragma unroll
    for (int o = 1; o < 64; o <<= 1) v += __shfl_xor(v, o);
    return v;
}
__device__ __forceinline__ unsigned cvtpk(float lo, float hi) { unsigned r; asm volatile("v_cvt_pk_bf16_f32 %0, %1, %2" : "=v"(r) : "v"(lo), "v"(hi)); return r; }
__device__ __forceinline__ float bf_lo(unsigned u) { return __uint_as_float(u << 16); }
__device__ __forceinline__ float bf_hi(unsigned u) { return __uint_as_float(u & 0xffff0000u); }
__device__ __forceinline__ float fsigmoid(float x) { return __builtin_amdgcn_rcpf(1.0f + __builtin_amdgcn_exp2f(-1.4426950408889634f * x)); }
__device__ __forceinline__ u32x4 pack8f(f32x4 a, f32x4 b) { u32x4 w = {cvtpk(a[0], a[1]), cvtpk(a[2], a[3]), cvtpk(b[0], b[1]), cvtpk(b[2], b[3])}; return w; }
__device__ __forceinline__ int seq_of_row(int m) { return m < MP ? (m >> 11) : NB + ((m - MP) >> 6); }

struct EpiIn {
    static constexpr bool PERM = true, AFTER_DRAIN = false, HAS_MID = false;
    unsigned char* ws; float* out; int layer; const float *qg, *kg; LAS float* xs;
    __device__ __forceinline__ void st8(bf16_t* p, f32x4 a, f32x4 b) const { *(u32x4*)p = pack8f(a, b); }
    __device__ __forceinline__ void operator()(const f32x4 (&acc)[2][2][4][2], const Unit& u, int wr, int wc, int fr, int fq) const {
        const int pn = u.pn, cw = wc * 32 + 8 * fq;
        const int rbase = u.pm * 256 + wr * 64 + fr;
        const bool prompt = u.pm < 32;
        if (pn < 8) {
            const bool isk = pn >= 4; const int hp = (pn & 3) * 2;
#pragma unroll
            for (int ai = 0; ai < 2; ++ai)
#pragma unroll
                for (int m = 0; m < 4; ++m)
#pragma unroll
                    for (int bj = 0; bj < 2; ++bj) {
                        const f32x4 a = acc[ai][bj][m][0], b = acc[ai][bj][m][1];
                        float s = (a[0] * a[0] + a[1] * a[1]) + (a[2] * a[2] + a[3] * a[3]) + (b[0] * b[0] + b[1] * b[1]) + (b[2] * b[2] + b[3] * b[3]);
                        s += __shfl_xor(s, 16); s += __shfl_xor(s, 32);
                        if (fq == 0) xs[((wr * 4 + wc) * 128 + ai * 64 + m * 16 + fr) * 2 + bj] = s;
                    }
            asm volatile("s_waitcnt lgkmcnt(0)" ::: "memory"); __builtin_amdgcn_s_barrier(); asm volatile("" ::: "memory");
            const float* g = isk ? kg : qg; const f32x4 g0 = *(const f32x4*)(g + cw), g1 = *(const f32x4*)(g + cw + 4);
            bf16_t* dst = (bf16_t*)(ws + (isk ? WS_K : WS_Q));
            float* fo = prompt ? out + O_KP + (size_t)layer * (MP * 1024) : out + O_KS + (size_t)layer * (MS * 1024) - (size_t)MP * 1024;
#pragma unroll
            for (int ai = 0; ai < 2; ++ai)
#pragma unroll
                for (int m = 0; m < 4; ++m) {
                    const int row = rbase + ai * 128 + m * 16;
#pragma unroll
                    for (int bj = 0; bj < 2; ++bj) {
                        const int xi = (wr * 4 * 128 + ai * 64 + m * 16 + fr) * 2 + bj;
                        const float tot = (xs[xi] + xs[xi + 256]) + (xs[xi + 512] + xs[xi + 768]);
                        const float rstd = __builtin_amdgcn_rsqf(tot * (1.0f / 128.0f) + EPS);
                        const f32x4 a = acc[ai][bj][m][0] * rstd * g0, b = acc[ai][bj][m][1] * rstd * g1;
                        const size_t o = (size_t)row * 1024 + (hp + bj) * 128 + cw;
                        st8(dst + o, a, b);
                        if (isk) { *(f32x4*)(fo + o) = a; *(f32x4*)(fo + o + 4) = b; }
                    }
                }
        } else if (pn < 12) {
            float* fo = prompt ? out + O_VP + (size_t)layer * (MP * 1024) : out + O_VS + (size_t)layer * (MS * 1024) - (size_t)MP * 1024;
#pragma unroll
            for (int ai = 0; ai < 2; ++ai)
#pragma unroll
                for (int m = 0; m < 4; ++m) {
                    const int row = rbase + ai * 128 + m * 16;
#pragma unroll
                    for (int bj = 0; bj < 2; ++bj) {
                        const f32x4 a = acc[ai][bj][m][0], b = acc[ai][bj][m][1];
                        const size_t o = (size_t)row * 1024 + (pn - 8) * 256 + bj * 128 + cw;
                        st8((bf16_t*)(ws + WS_V) + o, a, b); *(f32x4*)(fo + o) = a; *(f32x4*)(fo + o + 4) = b;
                    }
                }
        } else if (pn >= 16 && pn < 24) {
#pragma unroll
            for (int ai = 0; ai < 2; ++ai)
#pragma unroll
                for (int m = 0; m < 4; ++m) {
                    const int row = rbase + ai * 128 + m * 16;
                    f32x4 a = acc[ai][0][m][0], b = acc[ai][0][m][1]; const f32x4 ga = acc[ai][1][m][0], gb = acc[ai][1][m][1];
#pragma unroll
                    for (int i = 0; i < 4; ++i) { a[i] *= fsigmoid(ga[i]); b[i] *= fsigmoid(gb[i]); }
                    const int ch = (pn - 16) * 128 + cw;
                    st8((bf16_t*)(ws + WS_U) + (size_t)row * 1024 + ch, a, b);
                    int tl, sb; float* co;
                    if (prompt) { tl = (row & 2047) - (SEQ - 30); sb = row >> 11; co = out + O_CP + (size_t)layer * (NB * 30 * 1024); }
                    else { const int r2 = row - MP; tl = (r2 & 63) - (DS - 30); sb = r2 >> 6; co = out + O_CS + (size_t)layer * (DB * 30 * 1024); }
                    if (tl >= 0) { float* p = co + ((size_t)sb * 30 + tl) * 1024 + ch; *(f32x4*)p = a; *(f32x4*)(p + 4) = b; }
                }
        } else {
            const bool gate = pn >= 28;
            size_t woff; int ld, c0;
            if (pn < 16) { woff = WS_GA; ld = 1024; c0 = (pn - 12) * 256; }
            else if (pn < 28) { woff = WS_GB; ld = 1024; c0 = (pn - 24) * 256; }
            else if (pn < 36) { woff = WS_SA; ld = 2048; c0 = (pn - 28) * 256; }
            else { woff = WS_SB; ld = 2048; c0 = (pn - 36) * 256; }
            bf16_t* dst = (bf16_t*)(ws + woff);
#pragma unroll
            for (int ai = 0; ai < 2; ++ai)
#pragma unroll
                for (int m = 0; m < 4; ++m) {
                    const int row = rbase + ai * 128 + m * 16;
#pragma unroll
                    for (int bj = 0; bj < 2; ++bj) {
                        f32x4 a = acc[ai][bj][m][0], b = acc[ai][bj][m][1];
#pragma unroll
                        for (int i = 0; i < 4; ++i) { const float sa = fsigmoid(a[i]), sb = fsigmoid(b[i]); a[i] = gate ? sa : a[i] * sa; b[i] = gate ? sb : b[i] * sb; }
                        st8(dst + (size_t)row * ld + c0 + bj * 128 + cw, a, b);
                    }
                }
        }
    }
};
#ifndef MIDG
#define MIDG 4
#endif
struct EpiMerge {
    static constexpr bool PERM = true, AFTER_DRAIN = false, HAS_MID = true;
    const bf16_t *SA, *SB; bf16_t* MG;
    __device__ __forceinline__ void mid(f32x4 (&acc)[2][2][4][2], const Unit& u, int wr, int wc, int fr, int fq) const {
        int fr_ = fr; asm volatile("" : "+v"(fr_));
        const unsigned voff = (unsigned)(((wr * 64 + fr_) * 2048 + wc * 32 + 8 * fq) * 2);
        const size_t uoff = ((size_t)u.pm * 256 * 2048 + (size_t)u.pn * 256) * 2;
        const bf16_t* pa = (const bf16_t*)((const char*)SA + uoff + voff); const bf16_t* pb = (const bf16_t*)((const char*)SB + uoff + voff);
#pragma unroll
        for (int ai = 0; ai < 2; ++ai)
#pragma unroll
            for (int mp = 0; mp < 4; mp += MIDG) {
                u32x4 sa[MIDG][2], sb[MIDG][2];
#pragma unroll
                for (int q = 0; q < MIDG; ++q)
#pragma unroll
                    for (int bj = 0; bj < 2; ++bj) { const size_t o = (size_t)(ai * 128 + (mp + q) * 16) * 2048 + bj * 128; sa[q][bj] = *(const u32x4*)(pa + o); sb[q][bj] = *(const u32x4*)(pb + o); }
#pragma unroll
                for (int q = 0; q < MIDG; ++q)
#pragma unroll
                    for (int bj = 0; bj < 2; ++bj)
#pragma unroll
                        for (int j = 0; j < 4; ++j) {
                            const float r0 = bf_lo(sa[q][bj][j]) * __builtin_amdgcn_rcpf(bf_lo(sb[q][bj][j])), r1 = bf_hi(sa[q][bj][j]) * __builtin_amdgcn_rcpf(bf_hi(sb[q][bj][j]));
                            acc[ai][bj][mp + q][j >> 1][(j & 1) * 2] *= r0; acc[ai][bj][mp + q][j >> 1][(j & 1) * 2 + 1] *= r1;
                        }
#pragma unroll
                for (int q = 0; q < MIDG; ++q) asm volatile("" : "+v"(acc[ai][0][mp + q][0]), "+v"(acc[ai][0][mp + q][1]), "+v"(acc[ai][1][mp + q][0]), "+v"(acc[ai][1][mp + q][1]));
                asm volatile("" ::: "memory");
            }
    }
    __device__ __forceinline__ void operator()(const f32x4 (&acc)[2][2][4][2], const Unit& u, int wr, int wc, int fr, int fq) const {
        const int cw = wc * 32 + 8 * fq, rbase = u.pm * 256 + wr * 64 + fr;
#pragma unroll
        for (int ai = 0; ai < 2; ++ai)
#pragma unroll
            for (int m = 0; m < 4; ++m) {
                const int row = rbase + ai * 128 + m * 16;
#pragma unroll
                for (int bj = 0; bj < 2; ++bj) {
                    const size_t o = (size_t)row * 2048 + u.pn * 256 + bj * 128 + cw;
                    const u32x4 sb = *(const u32x4*)(SB + o);
                    f32x4 a = acc[ai][bj][m][0], b = acc[ai][bj][m][1];
                    a[0] *= bf_lo(sb[0]); a[1] *= bf_hi(sb[0]); a[2] *= bf_lo(sb[1]); a[3] *= bf_hi(sb[1]);
                    b[0] *= bf_lo(sb[2]); b[1] *= bf_hi(sb[2]); b[2] *= bf_lo(sb[3]); b[3] *= bf_hi(sb[3]);
                    *(u32x4*)(MG + o) = pack8f(a, b);
                }
                if (m & 1) asm volatile("" ::: "memory");
            }
    }
};
struct EpiOut {
    static constexpr bool PERM = false, AFTER_DRAIN = false, HAS_MID = false;
    const float* xp; const float* xsm; float* y; const float* gate;
    __device__ __forceinline__ void operator()(const f32x4 (&acc)[2][2][4][2], const Unit& u, int wr, int wc, int fr, int fq) const {
        const int rbase = u.pm * 256 + wr * 64 + fr, col0 = u.pn * 256 + wc * 32 + 4 * fq;
#pragma unroll
        for (int ai = 0; ai < 2; ++ai) {
            const int s = seq_of_row(u.pm * 256 + ai * 128 + wr * 64);
            f32x4 g[2][2];
#pragma unroll
            for (int bj = 0; bj < 2; ++bj)
#pragma unroll
                for (int n = 0; n < 2; ++n) g[bj][n] = *(const f32x4*)(gate + (size_t)s * 6144 + col0 + bj * 128 + n * 16);
#pragma unroll
            for (int m = 0; m < 4; ++m) {
                const int row = rbase + ai * 128 + m * 16;
                const float* xr = (row < MP) ? xp + (size_t)row * DM : xsm + (size_t)(row - MP) * DM;
                float* yr = y + (size_t)row * DM;
#pragma unroll
                for (int bj = 0; bj < 2; ++bj)
#pragma unroll
                    for (int n = 0; n < 2; ++n) { const int c = col0 + bj * 128 + n * 16; const f32x4 xv = *(const f32x4*)(xr + c); *(f32x4*)(yr + c) = xv + g[bj][n] * acc[ai][bj][m][n]; }
            }
        }
    }
};
#define XB_TMO      128
#define XB_XCNT(j)  (256  + 64 * (j))
#define XB_XSUB(j)  (1280 + 64 * (j))
#define XB_XGEN(j)  (2304 + 64 * (j))
#define XB_TOP      3328
#define XB_TOPGEN   3392
#define XCD_BAR_WORDS 3456
#define XB_SPIN_CAP (1u << 18)

__device__ __forceinline__ unsigned xb_ld(unsigned* p)              { return __hip_atomic_load(p, __ATOMIC_RELAXED, __HIP_MEMORY_SCOPE_AGENT); }
__device__ __forceinline__ unsigned xb_add(unsigned* p, unsigned v) { return __hip_atomic_fetch_add(p, v, __ATOMIC_RELAXED, __HIP_MEMORY_SCOPE_AGENT); }
__device__ __forceinline__ unsigned xb_xcc_id() { return (unsigned)__builtin_amdgcn_s_getreg((3 << 11) | 20) & 0xFu; }
#define XB_SPIN(cond, bar) do { unsigned _sp = 0; while (cond) { __builtin_amdgcn_s_sleep(1); \
    if ((++_sp & 255u) == 0u) { if (xb_ld(&(bar)[XB_TMO])) break; if (_sp > XB_SPIN_CAP) { atomicAdd(&(bar)[XB_TMO], 1u); break; } } } } while (0)

struct XcdBarrier {
    unsigned* bar; unsigned x;
    volatile LAS unsigned* st;
};

__device__ __forceinline__ XcdBarrier xcd_barrier_post(unsigned* bar, volatile LAS unsigned* st) {
    XcdBarrier b; b.bar = bar; b.x = xb_xcc_id(); b.st = st;
    if (threadIdx.x == 0) (void)xb_add(&bar[XB_XCNT(b.x)], 1u);
    return b;
}
__device__ __forceinline__ void xcd_barrier_complete(unsigned* bar, unsigned x, unsigned& nloc, unsigned& nx) {
    const unsigned G = gridDim.x * gridDim.y * gridDim.z;
    unsigned sum, cnt, mine, sp = 0u;
    for (;;) {
        sum = 0u; cnt = 0u; mine = 0u;
#pragma unroll
        for (unsigned j = 0; j < 16; ++j) { const unsigned c = xb_ld(&bar[XB_XCNT(j)]); sum += c; cnt += (c > 0u) ? 1u : 0u; mine = (j == x) ? c : mine; }
        if (sum == G) break;
        __builtin_amdgcn_s_sleep(1);
        if ((++sp & 255u) == 0u) { if (xb_ld(&bar[XB_TMO])) break; if (sp > XB_SPIN_CAP) { atomicAdd(&bar[XB_TMO], 1u); break; } }
    }
    nloc = mine > 0u ? mine : 1u; nx = cnt > 0u ? cnt : 1u;
}

__device__ __forceinline__ void xcd_barrier(const XcdBarrier& b) {
    asm volatile("s_waitcnt vmcnt(0)" ::: "memory");
    __syncthreads();
    if (threadIdx.x == 0) {
        unsigned* bar = b.bar;
        __builtin_amdgcn_s_waitcnt(0);
        unsigned nloc = b.st[0], nx = b.st[1];
        if (nloc == 0u) { xcd_barrier_complete(bar, b.x, nloc, nx); b.st[0] = nloc; b.st[1] = nx; }
        const unsigned old = xb_add(&bar[XB_XSUB(b.x)], 1u);
        const unsigned gen = old / nloc;
        if (old + 1u == (gen + 1u) * nloc) {
            __builtin_amdgcn_fence(__ATOMIC_RELEASE, "agent");
            asm volatile("s_waitcnt vmcnt(0)" ::: "memory");
            const unsigned og = xb_add(&bar[XB_TOP], 1u);
            const unsigned tg = og / nx;
            if (og + 1u == (tg + 1u) * nx) xb_add(&bar[XB_TOPGEN], 1u);
            else XB_SPIN(xb_ld(&bar[XB_TOPGEN]) == tg, bar);
            __builtin_amdgcn_fence(__ATOMIC_ACQUIRE, "agent");
            xb_add(&bar[XB_XGEN(b.x)], 1u);
            asm volatile("s_waitcnt vmcnt(0)" ::: "memory");
        } else {
            XB_SPIN(xb_ld(&bar[XB_XGEN(b.x)]) == gen, bar);
            __builtin_amdgcn_fence(__ATOMIC_ACQUIRE, "agent");
            asm volatile("s_waitcnt vmcnt(0)" ::: "memory");
        }
    }
    __syncthreads();
}

#ifndef FULL_STAGE
#define FULL_STAGE 0
#endif
namespace fa {
constexpr int D = 128, NW = 8, QBLK = 32, KVBLK = 64, QB = NW * QBLK;
constexpr int SHM_V = KVBLK * D * 2, SHM_K = KVBLK * D * 2;
constexpr int OFF_WS = 2 * SHM_V + 2 * SHM_K, OFF_BIAS = OFF_WS + NW * 64 * 4, OFF_RED = OFF_BIAS + 4224 * 4, OFF_OST = OFF_RED + 256, OFF_QP = OFF_OST + NW * (FULL_STAGE ? 8192 : 4096), QP = FULL_STAGE ? 0 : 4, LDS_BYTES = OFF_QP + QP * NW * 1024;
constexpr float SCALE = 0.08838834764831845f, INV_SCALE = 11.313708498984761f, THR = 8.f;
constexpr int RS = 1024;
constexpr int OS = 2048;
template <class A, class Bt> struct same_t { static constexpr bool v = false; };
template <class A> struct same_t<A, A> { static constexpr bool v = true; };
#define KSWZ(row, colB) ((row) * 256 + ((colB) ^ (((row) & 7) << 4)))
#define SBAR() __builtin_amdgcn_sched_barrier(0)
__device__ __forceinline__ int v_st(int k, int c) { const int kk = (k & ~0xC) | ((k & 4) << 1) | ((k & 8) >> 1); return ((kk >> 3) * 4 + (c >> 5)) * 512 + ((kk & 7) * 32 + (c & 31)) * 2; }
__device__ __forceinline__ int v_rd_base(int lane) { return ((lane & 3) << 3) | (((lane >> 2) & 3) << 6) | (((lane >> 4) & 1) << 5) | (((lane >> 5) & 1) << 8); }
constexpr int v_rd_off(int d0, int ks, int half) { return d0 * 512 + ks * 4096 + half * 2048; }
__device__ __forceinline__ int crow(int r, int hi) { return (r & 3) + 8 * (r >> 2) + 4 * hi; }
__device__ __forceinline__ bf16x8 pack8(f32x4 a, f32x4 b) { u32x4 w = {cvtpk(a[0], a[1]), cvtpk(a[2], a[3]), cvtpk(b[0], b[1]), cvtpk(b[2], b[3])}; return *reinterpret_cast<bf16x8*>(&w); }
__device__ __forceinline__ void mask_tile(f32x16& p0, f32x16& p1, int dq) {
    const float NEG = -__builtin_inff();
#pragma unroll
    for (int r = 0; r < 16; ++r) { const int c = (r & 3) + 8 * (r >> 2); if (dq - c < 0) p0[r] = NEG; if (dq - c - 32 < 0) p1[r] = NEG; }
}
__device__ __forceinline__ void partialSM(f32x16& p0, f32x16& p1, float& m_reg, float& mn, float& alpha) {
    float pmax = p0[0];
#pragma unroll
    for (int r = 1; r < 16; ++r) pmax = fmaxf(pmax, p0[r]);
#pragma unroll
    for (int r = 0; r < 16; ++r) pmax = fmaxf(pmax, p1[r]);
    { auto rr = __builtin_amdgcn_permlane32_swap(__float_as_uint(pmax), __float_as_uint(pmax), false, false); pmax = fmaxf(__uint_as_float(rr[0]), __uint_as_float(rr[1])); }
    constexpr float C2 = 1.4426950408889634f * SCALE;
    if (__builtin_expect(__all((pmax - m_reg) * SCALE <= THR), 1)) { mn = m_reg; alpha = 1.f; }
    else { mn = fmaxf(m_reg, pmax); alpha = __builtin_amdgcn_exp2f((m_reg - mn) * C2); m_reg = mn; }
    const float mnL = -mn * C2;
#pragma unroll
    for (int r = 0; r < 16; ++r) p0[r] = fmaf(p0[r], C2, mnL);
#pragma unroll
    for (int r = 0; r < 16; ++r) p1[r] = fmaf(p1[r], C2, mnL);
#pragma unroll
    for (int r = 0; r < 16; ++r) p0[r] = __builtin_amdgcn_exp2f(p0[r]);
}
__device__ __forceinline__ void finishSM(f32x16& p0, f32x16& p1, float alpha, float& l_reg, bf16x8& pa0, bf16x8& pa1, bf16x8& pa2, bf16x8& pa3) {
#pragma unroll
    for (int r = 0; r < 16; ++r) p1[r] = __builtin_amdgcn_exp2f(p1[r]);
    float ps = 0;
#pragma unroll
    for (int r = 0; r < 16; ++r) ps += p0[r];
#pragma unroll
    for (int r = 0; r < 16; ++r) ps += p1[r];
    { auto rr = __builtin_amdgcn_permlane32_swap(__float_as_uint(ps), __float_as_uint(ps), false, false); ps = __uint_as_float(rr[0]) + __uint_as_float(rr[1]); }
    l_reg = l_reg * alpha + ps;
#define PK4(P, B_, OUT) do { unsigned a0 = cvtpk(P[B_+0], P[B_+1]), a1 = cvtpk(P[B_+2], P[B_+3]);                          \
        unsigned b0 = cvtpk(P[B_+4], P[B_+5]), b1 = cvtpk(P[B_+6], P[B_+7]);                                             \
        auto r0 = __builtin_amdgcn_permlane32_swap(a0, b0, false, false); auto r1 = __builtin_amdgcn_permlane32_swap(a1, b1, false, false); \
        u32x4 w = {r0[0], r1[0], r0[1], r1[1]}; OUT = *reinterpret_cast<bf16x8*>(&w); } while (0)
    PK4(p0, 0, pa0); PK4(p0, 8, pa1); PK4(p1, 0, pa2); PK4(p1, 8, pa3);
#undef PK4
}
template <int KB, int QPK = QP>
__device__ __forceinline__ void qkt(f32x16& p0, f32x16& p1, const char* K_lds, const float* cb, int r32, int hi, const bf16x8* qr, const char* qp) {
    const f32x4* c4 = (const f32x4*)(cb + 4 * hi);
#pragma unroll
    for (int g = 0; g < 4; ++g) { const f32x4 a = c4[2 * g], b = c4[2 * g + 8];
        p0[4 * g] = a[0]; p0[4 * g + 1] = a[1]; p0[4 * g + 2] = a[2]; p0[4 * g + 3] = a[3];
        p1[4 * g] = b[0]; p1[4 * g + 1] = b[1]; p1[4 * g + 2] = b[2]; p1[4 * g + 3] = b[3]; }
    const char* kb[4];
#pragma unroll
    for (int dd = 0; dd < 4; ++dd) kb[dd] = K_lds + KB * SHM_K + KSWZ(r32, (dd * 16 + hi * 8) * 2);
#pragma unroll
    for (int d0 = 0; d0 < 8; ++d0) { const char* a = kb[d0 & 3] + (d0 >> 2) * 128;
        bf16x8 b0 = *reinterpret_cast<const bf16x8*>(a);
        bf16x8 b1 = *reinterpret_cast<const bf16x8*>(a + 32 * 256);
#ifdef T_NOQPREAD
        const bf16x8 q = qr[d0];
#else
        const bf16x8 q = d0 < 8 - QPK ? qr[d0] : *reinterpret_cast<const bf16x8*>(qp + (d0 - (8 - QPK)) * (NW * 1024));
#endif
        p0 = __builtin_amdgcn_mfma_f32_32x32x16_bf16(b0, q, p0, 0, 0, 0);
        p1 = __builtin_amdgcn_mfma_f32_32x32x16_bf16(b1, q, p1, 0, 0, 0); }
}
template <int VB>
__device__ __forceinline__ void pv_tile(f32x16* o, int vb0, bf16x8 pa0, bf16x8 pa1, bf16x8 pa2, bf16x8 pa3) {
#define TRRD(dst, off) asm volatile("ds_read_b64_tr_b16 %0, %1 offset:%2" : "=&v"(dst) : "v"(vb0), "i"(off) : "memory")
#define PV_D0(d0) do { s16x4 l0, l1, l2, l3, h0, h1, h2, h3; constexpr int b_ = VB * SHM_V + v_rd_off(d0, 0, 0); \
        TRRD(l0, b_); TRRD(h0, b_ + 2048); TRRD(l1, b_ + 4096); TRRD(h1, b_ + 6144); TRRD(l2, b_ + 8192); TRRD(h2, b_ + 10240); TRRD(l3, b_ + 12288); TRRD(h3, b_ + 14336); \
        asm volatile("s_waitcnt lgkmcnt(0)" ::: "memory"); SBAR();   \
        o[d0] = __builtin_amdgcn_mfma_f32_32x32x16_bf16(pa0, (bf16x8){l0[0], l0[1], l0[2], l0[3], h0[0], h0[1], h0[2], h0[3]}, o[d0], 0, 0, 0);   \
        o[d0] = __builtin_amdgcn_mfma_f32_32x32x16_bf16(pa1, (bf16x8){l1[0], l1[1], l1[2], l1[3], h1[0], h1[1], h1[2], h1[3]}, o[d0], 0, 0, 0);   \
        o[d0] = __builtin_amdgcn_mfma_f32_32x32x16_bf16(pa2, (bf16x8){l2[0], l2[1], l2[2], l2[3], h2[0], h2[1], h2[2], h2[3]}, o[d0], 0, 0, 0);   \
        o[d0] = __builtin_amdgcn_mfma_f32_32x32x16_bf16(pa3, (bf16x8){l3[0], l3[1], l3[2], l3[3], h3[0], h3[1], h3[2], h3[3]}, o[d0], 0, 0, 0); } while (0)
    PV_D0(0); PV_D0(1); PV_D0(2); PV_D0(3);
#undef PV_D0
#undef TRRD
}
template <class TKV> struct BlockRef { const bf16_t* Q; const TKV* K; const TKV* V; const TKV* K2; const TKV* V2; int nk1; bf16_t* O; const bf16_t* G; int P0; int live; int jlo, jhi; float* po; float* pml; };
struct Seam { bf16x8 qr[8]; bf16x8 st_v0, st_v1, st_k0, st_k1; f32x4 sf0, sf1, sf2, sf3; };
#define KPTR(ref, k0) ((k0) < (ref).nk1 ? (ref).K + (size_t)(k0) * RS : (ref).K2 + (size_t)((k0) - (ref).nk1) * RS)
#define VPTR(ref, k0) ((k0) < (ref).nk1 ? (ref).V + (size_t)(k0) * RS : (ref).V2 + (size_t)((k0) - (ref).nk1) * RS)
#define ROWP(p, rr) ((p) + (size_t)(rr) * RS + sc)
#define VMW() asm volatile("s_waitcnt vmcnt(0)" ::: "memory")
#define VMWN(n) asm volatile("s_waitcnt vmcnt(%0)" :: "i"(n) : "memory")
#define SLOAD_H(ref, k0) do { const TKV* kp_ = KPTR(ref, k0); const TKV* vp_ = VPTR(ref, k0);                                     \
        S.st_v0 = *(const bf16x8*)ROWP((const bf16_t*)vp_, sr); S.st_v1 = *(const bf16x8*)ROWP((const bf16_t*)vp_, 32 + sr);     \
        S.st_k0 = *(const bf16x8*)ROWP((const bf16_t*)kp_, sr); S.st_k1 = *(const bf16x8*)ROWP((const bf16_t*)kp_, 32 + sr); } while (0)
#define SWRITE_HK(bf) do { *(bf16x8*)(K_lds + (bf) * SHM_K + kws) = S.st_k0; *(bf16x8*)(K_lds + (bf) * SHM_K + kws + 32 * 256) = S.st_k1; } while (0)
#define SWRITE_HV(bf) do { *(bf16x8*)(V_lds + (bf) * SHM_V + vst0) = S.st_v0; *(bf16x8*)(V_lds + (bf) * SHM_V + vst1) = S.st_v1; } while (0)
#define SWRITE_H(bf) do { SWRITE_HV(bf); SWRITE_HK(bf); } while (0)
#define SLOAD_F(p_) do { const float* q_ = (const float*)(p_); S.sf0 = *(const f32x4*)ROWP(q_, sr); S.sf1 = *(const f32x4*)(ROWP(q_, sr) + 4);                \
                         S.sf2 = *(const f32x4*)ROWP(q_, 32 + sr); S.sf3 = *(const f32x4*)(ROWP(q_, 32 + sr) + 4); } while (0)
#define SWRITE_KF(bf) do { *(bf16x8*)(K_lds + (bf) * SHM_K + kws) = pack8(S.sf0, S.sf1); *(bf16x8*)(K_lds + (bf) * SHM_K + kws + 32 * 256) = pack8(S.sf2, S.sf3); } while (0)
#define SWRITE_VF(bf) do { *(bf16x8*)(V_lds + (bf) * SHM_V + vst0) = pack8(S.sf0, S.sf1); *(bf16x8*)(V_lds + (bf) * SHM_V + vst1) = pack8(S.sf2, S.sf3); } while (0)
template <class TKV>
__device__ __forceinline__ void attn_prime(const BlockRef<TKV>& cur, char* lds, Seam& S) {
    constexpr bool F32 = same_t<TKV, float>::v;
    const int tid = opaque_tid(), wid = __builtin_amdgcn_readfirstlane(tid >> 6), lane = tid & 63, r32 = lane & 31, hi = lane >> 5;
    const int sr = tid >> 4, sc = (tid & 15) * 8, kws = KSWZ(sr, sc * 2); char* K_lds = lds + 2 * SHM_V;
#pragma unroll
    for (int d0 = 0; d0 < 8; ++d0) S.qr[d0] = *(const bf16x8*)(cur.Q + (size_t)(wid * QBLK + r32) * RS + d0 * 16 + hi * 8);
    const int k0_ = cur.jlo * KVBLK;
    if constexpr (F32) { SLOAD_F(KPTR(cur, k0_)); VMW(); SWRITE_KF(0); SBAR(); SLOAD_F(VPTR(cur, k0_)); }
    else { SLOAD_H(cur, k0_); VMW(); SWRITE_HK(0); }
    __syncthreads();
}
template <class TKV, bool SKIP>
__device__ __forceinline__ void attn_block(const BlockRef<TKV>& cur, const BlockRef<TKV>& nxt, char* lds, Seam& S) {
    constexpr bool F32 = same_t<TKV, float>::v;
    const int tid = opaque_tid(), wid = __builtin_amdgcn_readfirstlane(tid >> 6), lane = tid & 63, r32 = lane & 31, hi = lane >> 5;
    const int j_lo = cur.jlo, NT = cur.jhi - cur.jlo;
    const bool act = !SKIP || (wid * QBLK < cur.live);
    const int kn0 = nxt.jlo * KVBLK;
    const int qlo = cur.P0 + wid * QBLK, qm = qlo + r32 - 4 * hi;
    char* V_lds = lds; char* K_lds = lds + 2 * SHM_V;
    float* ws = (float*)(lds + OFF_WS) + wid * 64; float* li_l = ws, * al_l = ws + 32;
    const float* cbias = (const float*)(lds + OFF_BIAS);
    float m_reg = -1e30f, l_reg = 0; f32x16 o[4] = {};
    const int sr = tid >> 4, sc = (tid & 15) * 8, vst0 = v_st(sr, sc), vst1 = v_st(32 + sr, sc), kws = KSWZ(sr, sc * 2);
    const int vb0 = (int)(uintptr_t)V_lds + v_rd_base(lane);
    char* qp = lds + OFF_QP + tid * 16;
#pragma unroll
    for (int j_ = 0; j_ < QP; ++j_) *reinterpret_cast<bf16x8*>(qp + j_ * (NW * 1024)) = S.qr[8 - QP + j_];
#define RESC(a) do { if (__any((a) < 1.f)) { if (hi == 0) al_l[r32] = (a); asm volatile("s_waitcnt lgkmcnt(0)" ::: "memory");              \
                     for (int d_ = 0; d_ < 4; ++d_) for (int r = 0; r < 16; ++r) o[d_][r] *= al_l[crow(r, hi)]; } } while (0)
#define KBASE(t) ((j_lo + (t)) * KVBLK)
#define MASKT(P0_, P1_, t) do { const int kb_ = KBASE(t); if (kb_ + KVBLK - 1 > qlo) mask_tile(P0_, P1_, qm - kb_); } while (0)
    constexpr int NQL = 8;
#define SEAM_K0() do { VMWN(NQL); if constexpr (F32) { SWRITE_KF(0); SBAR(); SLOAD_F(VPTR(nxt, kn0)); } else { SWRITE_HK(0); } SBAR(); } while (0)
    f32x16 pA0, pA1, pB0, pB1; float mnA, mnB, alA, alB; bf16x8 pa0, pa1, pa2, pa3;
    if constexpr (F32) { VMW(); SWRITE_VF(0); SBAR(); } else { SWRITE_HV(0); SBAR(); }
    if (NT > 1) { if constexpr (F32) SLOAD_F(KPTR(cur, KBASE(1))); else SLOAD_H(cur, KBASE(1)); }
    SBAR(); if (act) qkt<0>(pA0, pA1, K_lds, cbias + KBASE(0), r32, hi, S.qr, qp);
    if constexpr (F32) { if (NT > 1) { VMW(); SWRITE_KF(1); SBAR(); SLOAD_F(VPTR(cur, KBASE(1))); } }
    if (act) { MASKT(pA0, pA1, 0); partialSM(pA0, pA1, m_reg, mnA, alA); }
    if (NT > 1) { VMW(); if constexpr (F32) { SWRITE_VF(1); SBAR(); if (NT > 2) SLOAD_F(KPTR(cur, KBASE(2))); } else SWRITE_H(1); }
    __syncthreads();
#define HALF_STEP(PX0, PX1, mnX, alX, PY0, PY1, alY, t, KB, VB, SB) do {                                                      \
        SBAR(); if (act) { qkt<KB>(PX0, PX1, K_lds, cbias + KBASE(t), r32, hi, S.qr, qp);                                         \
        finishSM(PY0, PY1, alY, l_reg, pa0, pa1, pa2, pa3); } SBAR();                                                         \
        if ((t) + 1 < NT) { if constexpr (F32) { VMW(); SWRITE_KF(SB); SBAR(); SLOAD_F(VPTR(cur, KBASE((t) + 1))); }          \
                            else { SLOAD_H(cur, KBASE((t) + 1)); } SBAR(); }                                                  \
        if (act) { pv_tile<VB>(o, vb0, pa0, pa1, pa2, pa3); MASKT(PX0, PX1, (t)); partialSM(PX0, PX1, m_reg, mnX, alX); }     \
        __syncthreads();                                                                                                      \
        if ((t) + 1 < NT) { VMW(); if constexpr (F32) { SWRITE_VF(SB); SBAR(); if ((t) + 2 < NT) SLOAD_F(KPTR(cur, KBASE((t) + 2))); } \
                            else { SWRITE_H(SB); } }                                                                          \
        if (act) RESC(alX); __syncthreads(); } while (0)
    for (int t = 1; t + 1 < NT; t += 2) {
        HALF_STEP(pB0, pB1, mnB, alB, pA0, pA1, alA, t, 1, 0, 0);
        HALF_STEP(pA0, pA1, mnA, alA, pB0, pB1, alB, t + 1, 0, 1, 1);
    }
    const bool even = (NT & 1) == 0;
    if (even) { SBAR(); if (act) qkt<1>(pB0, pB1, K_lds, cbias + KBASE(NT - 1), r32, hi, S.qr, qp); SBAR(); }
    if constexpr (F32) { SLOAD_F(KPTR(nxt, kn0)); SBAR(); } else { SLOAD_H(nxt, kn0); SBAR(); }
#pragma unroll
    for (int d0 = 0; d0 < 8; ++d0) S.qr[d0] = *(const bf16x8*)(nxt.Q + (size_t)(wid * QBLK + r32) * RS + d0 * 16 + hi * 8);
    SBAR();
    if (act) { finishSM(pA0, pA1, alA, l_reg, pa0, pa1, pa2, pa3); SBAR();
        pv_tile<0>(o, vb0, pa0, pa1, pa2, pa3); }
    if (even) { if (act) { MASKT(pB0, pB1, NT - 1); partialSM(pB0, pB1, m_reg, mnB, alB); } __syncthreads(); if (act) { RESC(alB);
        finishSM(pB0, pB1, alB, l_reg, pa0, pa1, pa2, pa3); SBAR(); pv_tile<1>(o, vb0, pa0, pa1, pa2, pa3); } }
    SBAR(); SEAM_K0();
    if (cur.po != nullptr) {
        if (wid * QBLK < cur.live) {
            int e_ = lane; asm volatile("" : "+v"(e_));
            const int er32 = e_ & 31, ehi = e_ >> 5;
            if (ehi == 0) { float* pm = cur.pml + (size_t)(wid * QBLK + er32) * 2; pm[0] = m_reg; pm[1] = l_reg; }
            float* pp = cur.po + (size_t)(wid * QBLK + 4 * ehi) * D + er32;
#pragma unroll
            for (int r = 0; r < 16; ++r) { const int oc = (r & 3) + 8 * (r >> 2);
#pragma unroll
                for (int d0 = 0; d0 < 4; ++d0) pp[oc * D + d0 * 32] = o[d0][r]; }
        }
    } else {
#if FULL_STAGE
    if (hi == 0) li_l[r32] = l_reg; asm volatile("s_waitcnt lgkmcnt(0)" ::: "memory");
    if (wid * QBLK < cur.live) {
        int e_ = lane; asm volatile("" : "+v"(e_));
        const int erow = e_ >> 4, ech = (e_ & 15) * 8, er32 = e_ & 31, ehi = e_ >> 5;
        bf16_t* stg = (bf16_t*)(lds + OFF_OST) + wid * 4096;
        const bf16_t* gp = cur.G + (size_t)(wid * QBLK + erow) * RS + ech; bf16_t* op = cur.O + (size_t)(wid * QBLK + erow) * OS + ech;
        bf16_t* sp0 = stg + erow * 128 + ech;
#pragma unroll
        for (int i = 0; i < 8; ++i) { *(u32x4*)(sp0 + i * 512) = *(const u32x4*)gp; gp += 4 * RS; }
        asm volatile("s_waitcnt lgkmcnt(0)" ::: "memory");
        bf16_t* sq = stg + ehi * 512 + er32; const float* lq = li_l + 4 * ehi;
#pragma unroll
        for (int r = 0; r < 16; ++r) { const int oc = (r & 3) + 8 * (r >> 2); const float rl = __builtin_amdgcn_rcpf(lq[oc]);
#pragma unroll
            for (int d0 = 0; d0 < 4; ++d0) { bf16_t* sp = sq + oc * 128 + d0 * 32; const float g = __uint_as_float((unsigned)(*sp) << 16);
                *sp = (bf16_t)(cvtpk(o[d0][r] * rl * g, 0.f) & 0xffffu); } }
        asm volatile("s_waitcnt lgkmcnt(0)" ::: "memory");
#pragma unroll
        for (int i = 0; i < 8; ++i) { *(u32x4*)op = *(const u32x4*)(sp0 + i * 512); op += 4 * OS; }
#else
    if (hi == 0) li_l[r32] = l_reg; asm volatile("s_waitcnt lgkmcnt(0)" ::: "memory");
    if (wid * QBLK < cur.live) {
        int e_ = lane; asm volatile("" : "+v"(e_));
        const int erow = e_ >> 3, ech = (e_ & 7) * 8, er32 = e_ & 31, ehi = e_ >> 5;
        bf16_t* stg = (bf16_t*)(lds + OFF_OST) + wid * 2048;
        bf16_t* sp0 = stg + erow * 64 + ech; bf16_t* sq = stg + ehi * 256 + er32; const float* lq = li_l + 4 * ehi;
        float rl[16];
#pragma unroll
        for (int r = 0; r < 16; ++r) rl[r] = __builtin_amdgcn_rcpf(lq[(r & 3) + 8 * (r >> 2)]);
#pragma unroll
        for (int hc = 0; hc < 2; ++hc) {
            const bf16_t* gp = cur.G + (size_t)(wid * QBLK + erow) * RS + hc * 64 + ech; bf16_t* op = cur.O + (size_t)(wid * QBLK + erow) * OS + hc * 64 + ech;
#pragma unroll
            for (int i = 0; i < 4; ++i) { *(u32x4*)(sp0 + i * 512) = *(const u32x4*)gp; gp += 8 * RS; }
            asm volatile("s_waitcnt lgkmcnt(0)" ::: "memory");
#pragma unroll
            for (int r = 0; r < 16; ++r) { const int oc = (r & 3) + 8 * (r >> 2);
#pragma unroll
                for (int dd = 0; dd < 2; ++dd) { bf16_t* sp = sq + oc * 64 + dd * 32; const float g = __uint_as_float((unsigned)(*sp) << 16);
                    *sp = (bf16_t)(cvtpk(o[2 * hc + dd][r] * rl[r] * g, 0.f) & 0xffffu); } }
            asm volatile("s_waitcnt lgkmcnt(0)" ::: "memory");
#pragma unroll
            for (int i = 0; i < 4; ++i) { *(u32x4*)op = *(const u32x4*)(sp0 + i * 512); op += 8 * OS; }
            asm volatile("s_waitcnt lgkmcnt(0)" ::: "memory");
        }
#endif
    }
    }
    __syncthreads();
#undef RESC
#undef KBASE
#undef MASKT
#undef SEAM_K0
#undef HALF_STEP
}

__device__ __forceinline__ void sample_item(const BlockRef<float>& cur, char* lds) {
    const int tid = opaque_tid(), wid = __builtin_amdgcn_readfirstlane(tid >> 6), lane = tid & 63, r32 = lane & 31, hi = lane >> 5;
    const int j_lo = cur.jlo, NT = cur.jhi - cur.jlo;
    const bool comp = wid < 2, ldr = wid >= 4;
    const int qlo = cur.P0 + wid * QBLK, qm = qlo + r32 - 4 * hi;
    char* V_lds = lds; char* K_lds = lds + 2 * SHM_V;
    float* ws = (float*)(lds + OFF_WS) + wid * 64; float* al_l = ws + 32;
    const float* cbias = (const float*)(lds + OFF_BIAS);
    const int vb0 = (int)(uintptr_t)V_lds + v_rd_base(lane);
    const int lt = tid & 255, lsr = lt >> 4, sc = (lt & 15) * 8, kws = KSWZ(lsr, sc * 2), vst0 = v_st(lsr, sc);
#define KBASE(t) ((j_lo + (t)) * KVBLK)
#define LLOAD(set, t) do { const float* kp_ = (const float*)KPTR(cur, KBASE(t)) + (size_t)lsr * RS + sc; const float* vp_ = (const float*)VPTR(cur, KBASE(t)) + (size_t)lsr * RS + sc; \
        _Pragma("unroll") for (int i_ = 0; i_ < 4; ++i_) { kr[set][2 * i_] = *(const f32x4*)(kp_ + (size_t)i_ * 16 * RS); kr[set][2 * i_ + 1] = *(const f32x4*)(kp_ + (size_t)i_ * 16 * RS + 4); } \
        _Pragma("unroll") for (int i_ = 0; i_ < 4; ++i_) { vr[set][2 * i_] = *(const f32x4*)(vp_ + (size_t)i_ * 16 * RS); vr[set][2 * i_ + 1] = *(const f32x4*)(vp_ + (size_t)i_ * 16 * RS + 4); } } while (0)
#define LWRITE_K(set, buf) do { _Pragma("unroll") for (int i_ = 0; i_ < 4; ++i_) *(bf16x8*)(K_lds + (buf) * SHM_K + kws + i_ * 4096) = pack8(kr[set][2 * i_], kr[set][2 * i_ + 1]); } while (0)
#define LWRITE_V(set, buf) do { _Pragma("unroll") for (int i_ = 0; i_ < 4; ++i_) *(bf16x8*)(V_lds + (buf) * SHM_V + vst0 + i_ * 4096) = pack8(vr[set][2 * i_], vr[set][2 * i_ + 1]); } while (0)
#define RESC(a) do { if (__any((a) < 1.f)) { if (hi == 0) al_l[r32] = (a); asm volatile("s_waitcnt lgkmcnt(0)" ::: "memory");              \
                     for (int d_ = 0; d_ < 4; ++d_) for (int r = 0; r < 16; ++r) o[d_][r] *= al_l[crow(r, hi)]; } } while (0)
#define MASKT(P0_, P1_, t) do { const int kb_ = KBASE(t); if (kb_ + KVBLK - 1 > qlo) mask_tile(P0_, P1_, qm - kb_); } while (0)
#define BAR2() do { __syncthreads(); __syncthreads(); } while (0)
    if (ldr) {
        f32x4 kr[2][8], vr[2][8];
        LLOAD(0, 0); if (NT > 1) LLOAD(1, 1); LWRITE_K(0, 0); LWRITE_V(0, 0); if (NT > 2) LLOAD(0, 2);
        __syncthreads();
#define LSTEP(t, KB) do { if ((t) + 1 < NT) LWRITE_K(1 - KB, 1 - KB); __syncthreads(); if ((t) + 1 < NT) LWRITE_V(1 - KB, 1 - KB); if ((t) + 3 < NT) LLOAD(1 - KB, (t) + 3); __syncthreads(); } while (0)
        LSTEP(0, 0);
        for (int t = 1; t + 1 < NT; t += 2) { LSTEP(t, 1); LSTEP(t + 1, 0); }
        if ((NT & 1) == 0) LSTEP(NT - 1, 1);
#undef LSTEP
    } else if (comp) {
        float m_reg = -1e30f, l_reg = 0; f32x16 o[4] = {};
        f32x16 pA0, pA1, pB0, pB1; float mnA, mnB, alA, alB; bf16x8 pa0, pa1, pa2, pa3; bf16x8 qr[8];
#pragma unroll
        for (int d0 = 0; d0 < 8; ++d0) qr[d0] = *(const bf16x8*)(cur.Q + (size_t)(wid * QBLK + r32) * RS + d0 * 16 + hi * 8);
        char* qp = lds + OFF_QP + tid * 16;
#pragma unroll
        for (int j_ = 0; j_ < QP; ++j_) *reinterpret_cast<bf16x8*>(qp + j_ * (NW * 1024)) = qr[8 - QP + j_];
        __syncthreads();
#define CSTEP(PX0, PX1, mnX, alX, PY0, PY1, alY, t, KB, VB, FIRST) do {                                                         \
        SBAR(); qkt<KB>(PX0, PX1, K_lds, cbias + KBASE(t), r32, hi, qr, qp);                                                    \
        if (!(FIRST)) { finishSM(PY0, PY1, alY, l_reg, pa0, pa1, pa2, pa3); SBAR(); pv_tile<VB>(o, vb0, pa0, pa1, pa2, pa3); }  \
        MASKT(PX0, PX1, (t)); partialSM(PX0, PX1, m_reg, mnX, alX);                                                             \
        __syncthreads();                                                                                                        \
        if (!(FIRST)) RESC(alX);                                                                                                \
        __syncthreads(); } while (0)
        CSTEP(pA0, pA1, mnA, alA, pB0, pB1, alB, 0, 0, 1, true);
        for (int t = 1; t + 1 < NT; t += 2) {
            CSTEP(pB0, pB1, mnB, alB, pA0, pA1, alA, t, 1, 0, false);
            CSTEP(pA0, pA1, mnA, alA, pB0, pB1, alB, t + 1, 0, 1, false);
        }
        if ((NT & 1) == 0) { CSTEP(pB0, pB1, mnB, alB, pA0, pA1, alA, NT - 1, 1, 0, false);
            finishSM(pB0, pB1, alB, l_reg, pa0, pa1, pa2, pa3); SBAR(); pv_tile<1>(o, vb0, pa0, pa1, pa2, pa3); }
        else { finishSM(pA0, pA1, alA, l_reg, pa0, pa1, pa2, pa3); SBAR(); pv_tile<0>(o, vb0, pa0, pa1, pa2, pa3); }
#undef CSTEP
        int e_ = lane; asm volatile("" : "+v"(e_));
        const int er32 = e_ & 31, ehi = e_ >> 5;
        if (ehi == 0) { float* pm = cur.pml + (size_t)(wid * QBLK + er32) * 2; pm[0] = m_reg; pm[1] = l_reg; }
        float* pp = cur.po + (size_t)(wid * QBLK + 4 * ehi) * D + er32;
#pragma unroll
        for (int r = 0; r < 16; ++r) { const int oc = (r & 3) + 8 * (r >> 2);
#pragma unroll
            for (int d0 = 0; d0 < 4; ++d0) pp[oc * D + d0 * 32] = o[d0][r]; }
    } else {
        __syncthreads();
        BAR2();
        for (int t = 1; t + 1 < NT; t += 2) { BAR2(); BAR2(); }
        if ((NT & 1) == 0) BAR2();
    }
    __syncthreads();
#undef BAR2
#undef KBASE
#undef LLOAD
#undef LWRITE_K
#undef LWRITE_V
#undef RESC
#undef MASKT
}
#undef ROWP
#undef VMW
#undef VMWN
#undef SLOAD_H
#undef SWRITE_HK
#undef SWRITE_HV
#undef SWRITE_H
#undef SLOAD_F
#undef SWRITE_KF
#undef SWRITE_VF
#undef KPTR
#undef VPTR
#undef SBAR
}

struct Args { const float* in[22]; float* out; unsigned char* ws; int ph_lo, ph_hi; };
enum { I_XP = 0, I_XS, I_CP, I_CS, I_CK, I_CV, I_CLF, I_SCONV, I_WADA, I_BADA, I_NORMG, I_WIN, I_BF, I_QG, I_KG, I_CONVW, I_CONVB, I_LNG, I_LNB, I_WOA, I_WOB, I_WOUT };

__device__ __forceinline__ int srccol(int n) {
    const int tile = n >> 8, r = n & 255;
    if (tile < 12) return n;
    if (tile < 16) return 3080 + (n - 3072);
    if (tile < 24) { const int j = tile - 16; return r < 128 ? 4104 + 128 * j + r : 5128 + 128 * j + (r - 128); }
    if (tile < 28) return 6152 + (n - 6144);
    if (tile < 36) return 7176 + (n - 7168);
    return 9224 + (n - 9216);
}
__device__ __forceinline__ void transpose_item(const float* W, int ldw, int k0, int ns0, bf16_t* WT, int ldt, int nd0, int kd0, LAS float* scr, int lane) {
#pragma unroll 8
    for (int i = 0; i < 32; ++i) { const int kk = 2 * i + (lane >> 5); scr[kk * 33 + (lane & 31)] = W[(size_t)(k0 + kk) * ldw + ns0 + (lane & 31)]; }
    asm volatile("s_waitcnt lgkmcnt(0)" ::: "memory");
    const int c = lane & 7;
#pragma unroll
    for (int j = 0; j < 4; ++j) { const int n = (lane >> 3) + 8 * j; const LAS float* s = scr + (8 * c) * 33 + n;
        u32x4 o; o.x = cvtpk(s[0 * 33], s[1 * 33]); o.y = cvtpk(s[2 * 33], s[3 * 33]); o.z = cvtpk(s[4 * 33], s[5 * 33]); o.w = cvtpk(s[6 * 33], s[7 * 33]);
        *(u32x4*)(WT + (size_t)(nd0 + n) * ldt + kd0 + 8 * c) = o; }
    asm volatile("s_waitcnt lgkmcnt(0)" ::: "memory");
}

__device__ __forceinline__ void p0_prologue(const Args& A, LAS unsigned char* lds, int wg_, int G_) {
    const int wg = opaque_s(wg_), G = opaque_s(G_);
    const int tid = opaque_tid(), lane = tid & 63, wave = __builtin_amdgcn_readfirstlane(tid >> 6);
    unsigned char* ws = opaque_p(A.ws);
    {
        LAS float* sc = (LAS float*)lds;
        LAS float* red = (LAS float*)(lds + 81920);
        float* mod = (float*)(ws + WS_MOD);
        for (int u = wg; u < 2 * 96; u += G) {
            const int l = u / 96, cb = u % 96, col = cb * 64 + lane;
            const float* W = A.in[I_WADA] + (size_t)l * DM * 6144;
            float acc[NSEQ];
#pragma unroll
            for (int s = 0; s < NSEQ; ++s) acc[s] = 0.f;
            for (int half = 0; half < 2; ++half) {
                __syncthreads();
                for (int e = tid; e < 1024 * NSEQ; e += NTHR) { const int kk = e / NSEQ, s = e % NSEQ; const int k = half * 1024 + kk;
                    const float c = s < NB ? A.in[I_CP][s * DM + k] : A.in[I_CS][(s - NB) * DM + k];
                    sc[e] = c * fsigmoid(c); }
                __syncthreads();
                const int kb = wave * 128;
#pragma unroll 4
                for (int kk = 0; kk < 128; ++kk) {
                    const float w = W[(size_t)(half * 1024 + kb + kk) * 6144 + col];
                    const LAS f32x4* s4 = (const LAS f32x4*)(sc + (kb + kk) * NSEQ);
#pragma unroll
                    for (int q = 0; q < 5; ++q) { const f32x4 v = s4[q]; acc[4 * q] += w * v[0]; acc[4 * q + 1] += w * v[1]; acc[4 * q + 2] += w * v[2]; acc[4 * q + 3] += w * v[3]; }
                }
            }
#pragma unroll
            for (int s = 0; s < NSEQ; ++s) red[(wave * NSEQ + s) * 64 + lane] = acc[s];
            __syncthreads();
            for (int e = tid; e < NSEQ * 64; e += NTHR) { const int s = e >> 6, c = e & 63; float t = 0.f;
#pragma unroll
                for (int w = 0; w < 8; ++w) t += red[(w * NSEQ + s) * 64 + c];
                mod[((size_t)l * NSEQ + s) * 6144 + cb * 64 + c] = t + A.in[I_BADA][l * 6144 + cb * 64 + c]; }
            __syncthreads();
        }
    }
    const int gw = wg * NWAVES + wave, NGW = G * NWAVES;
    {
        float* FC = (float*)(ws + WS_FC);
        for (int u = gw; u < DEPTH * DB * NH; u += NGW) {
            const int h = u % NH, lb = u / NH; const float* src = A.in[I_CLF] + (size_t)lb * PAST * NH + h; float* dst = FC + (size_t)u * PAST;
            float carry = 0.f;
            for (int j = 0; j < PAST / 64; ++j) {
                float v = src[(size_t)(j * 64 + lane) * NH];
#pragma unroll
                for (int o = 1; o < 64; o <<= 1) { const float t = __shfl_up(v, o); if (lane >= o) v += t; }
                v += carry; dst[j * 64 + lane] = v; carry = __shfl(v, 63);
            }
        }
    }
    {
        float* WF = (float*)(ws + WS_WF);
        for (int e = wg * NTHR + tid; e < DEPTH * NH * DM; e += G * NTHR) { const int k = e % DM, h = (e / DM) % NH, l = e / (DM * NH);
            WF[e] = A.in[I_WIN][((size_t)l * DM + k) * DIN + 3072 + h]; }
    }
    {
        __syncthreads();
        LAS float* scr = (LAS float*)(lds + wave * 16384);
        constexpr int I_IN = (NIN / 32) * (DM / 64), I_OA = (DM / 32) * (DA / 64), I_OUT = (DM / 32) * (DM / 64), PER_L = I_IN + 2 * I_OA + I_OUT;
        for (int it = gw; it < DEPTH * PER_L; it += NGW) {
            const int l = it / PER_L; int r = it % PER_L;
            if (r < I_IN) { const int nb = r % (NIN / 32), kb = r / (NIN / 32);
                transpose_item(A.in[I_WIN] + (size_t)l * DM * DIN, DIN, kb * 64, srccol(nb * 32), (bf16_t*)(ws + WS_WIN) + (size_t)l * NIN * DM, DM, nb * 32, kb * 64, scr, lane); continue; }
            r -= I_IN;
            if (r < 2 * I_OA) { const int which = r / I_OA; r %= I_OA; const int nb = r % (DM / 32), kb = r / (DM / 32);
                transpose_item(A.in[which ? I_WOB : I_WOA] + (size_t)l * DA * DM, DM, kb * 64, nb * 32, (bf16_t*)(ws + WS_WOAB) + (size_t)l * DM * DM, DM, nb * 32, which * 1024 + kb * 64, scr, lane); continue; }
            r -= 2 * I_OA;
            { const int nb = r % (DM / 32), kb = r / (DM / 32);
                transpose_item(A.in[I_WOUT] + (size_t)l * DM * DM, DM, kb * 64, nb * 32, (bf16_t*)(ws + WS_WOUT) + (size_t)l * DM * DM, DM, nb * 32, kb * 64, scr, lane); }
        }
    }
}

__device__ __forceinline__ void p1_norm(const Args& A, int l, LAS unsigned char* lds, int wg_, int G_) {
    const int wg = opaque_s(wg_), G = opaque_s(G_);
    const int tid = opaque_tid(), lane = tid & 63, wave = __builtin_amdgcn_readfirstlane(tid >> 6);
    unsigned char* ws = opaque_p(A.ws);
    LAS float* wf = (LAS float*)lds;
    LAS float* gs = (LAS float*)(lds + 65536);
    LAS float* sh = (LAS float*)(lds + 65536 + 8192);
    const float* WF = (const float*)(ws + WS_WF) + (size_t)l * NH * DM;
    const float* mod = (const float*)(ws + WS_MOD) + (size_t)l * NSEQ * 6144;
    bf16_t* H = (bf16_t*)(ws + WS_H);
    for (int e = tid; e < NH * DM / 4; e += NTHR) ((LAS f32x4*)wf)[e] = ((const f32x4*)WF)[e];
    const float* xp = l == 0 ? A.in[I_XP] : A.out + O_YP; const float* xs = l == 0 ? A.in[I_XS] : A.out + O_YS;
    float bfv = 0.f; if (lane < NH) bfv = A.in[I_BF][l * NH + lane];
    int cur_s = -1;
    for (int u = wg; u < MT / 32; u += G) {
        const int row0 = u * 32, s = seq_of_row(row0);
        if (s != cur_s) {
            __syncthreads();
            for (int e = tid; e < DM; e += NTHR) { gs[e] = A.in[I_NORMG][l * DM + e] * (1.0f + mod[(size_t)s * 6144 + DM + e]); sh[e] = mod[(size_t)s * 6144 + e]; }
            cur_s = s;
        }
        __syncthreads();
#pragma unroll 1
        for (int rr = 0; rr < 4; ++rr) {
            const int row = row0 + wave * 4 + rr;
            const float* xrow = row < MP ? xp + (size_t)row * DM : xs + (size_t)(row - MP) * DM;
            const f32x4* xr = (const f32x4*)xrow + lane;
            f32x4 v[8]; float ss = 0.f;
#pragma unroll
            for (int j = 0; j < 8; ++j) { v[j] = xr[64 * j]; ss += (v[j][0] * v[j][0] + v[j][1] * v[j][1]) + (v[j][2] * v[j][2] + v[j][3] * v[j][3]); }
            const float rstd = __builtin_amdgcn_rsqf(wave_sum(ss) * (1.0f / DM) + EPS);
            u32x2* ho = (u32x2*)(H + (size_t)row * DM) + lane;
#pragma unroll
            for (int j = 0; j < 8; ++j) { const f32x4 g4 = ((const LAS f32x4*)gs)[lane + 64 * j], s4 = ((const LAS f32x4*)sh)[lane + 64 * j];
                v[j] = v[j] * rstd * g4 + s4; u32x2 w; w.x = cvtpk(v[j][0], v[j][1]); w.y = cvtpk(v[j][2], v[j][3]); ho[64 * j] = w; }
            float fl[NH];
#pragma unroll
            for (int h = 0; h < NH; ++h) { float a = 0.f;
#pragma unroll
                for (int j = 0; j < 8; ++j) { const f32x4 w4 = ((const LAS f32x4*)(wf + h * DM))[lane + 64 * j]; a += (v[j][0] * w4[0] + v[j][1] * w4[1]) + (v[j][2] * w4[2] + v[j][3] * w4[3]); }
                fl[h] = wave_sum(a); }
            float mine = 0.f;
#pragma unroll
            for (int h = 0; h < NH; ++h) mine = lane == h ? fl[h] : mine;
            if (lane < NH) { const float z = mine + bfv; const float lf = fminf(z, 0.f) - log1pf(__expf(-fabsf(z)));
                float* o = row < MP ? A.out + O_FP + ((size_t)l * MP + row) * NH : A.out + O_FS + ((size_t)l * MS + (row - MP)) * NH; o[lane] = lf; }
        }
    }
}

__device__ __forceinline__ void fill_bias_prompt(char* lds, const float* logf  , int nkeys) {
    const int tid = opaque_tid(), lane = tid & 63, wave = tid >> 6;
    float* cb = (float*)(lds + fa::OFF_BIAS); float* red = (float*)(lds + fa::OFF_RED);
    float v[4]; float run = 0.f;
#pragma unroll
    for (int j = 0; j < 4; ++j) { const int k = 4 * tid + j; const float x = k < nkeys ? logf[(size_t)k * NH] : 0.f; run += x; v[j] = run; }
    float incl = run;
#pragma unroll
    for (int o = 1; o < 64; o <<= 1) { const float t = __shfl_up(incl, o); if (lane >= o) incl += t; }
    if (lane == 63) red[wave] = incl;
    __syncthreads();
    float off = incl - run;
    for (int w = 0; w < wave; ++w) off += red[w];
#pragma unroll
    for (int j = 0; j < 4; ++j) { const int k = 4 * tid + j; if (k < nkeys) cb[k] = -(off + v[j]) * fa::INV_SCALE; }
    __syncthreads();
}
__device__ __forceinline__ void fill_bias_sample(char* lds, const float* FCrow, const float* logf_new  ) {
    const int tid = opaque_tid(), lane = tid & 63;
    float* cb = (float*)(lds + fa::OFF_BIAS);
    for (int k = tid; k < PAST; k += NTHR) cb[k] = -FCrow[k] * fa::INV_SCALE;
    if (tid < 64) { float v = logf_new[(size_t)lane * NH];
#pragma unroll
        for (int o = 1; o < 64; o <<= 1) { const float t = __shfl_up(v, o); if (lane >= o) v += t; }
        cb[PAST + lane] = -(FCrow[PAST - 1] + v) * fa::INV_SCALE; }
    __syncthreads();
}
__device__ __forceinline__ void conv_unit(const Args& A, int l, char* lds, int u) {
    const int tid = opaque_tid(), lane = tid & 63, wave = __builtin_amdgcn_readfirstlane(tid >> 6);
    unsigned char* ws = opaque_p(A.ws);
    const bf16_t* U = (const bf16_t*)(ws + WS_U); const bf16_t* GB = (const bf16_t*)(ws + WS_GB); bf16_t* YAB = (bf16_t*)(ws + WS_YAB);
    int s, t0, mrow0; bool prompt = u < 512;
    if (prompt) { s = u >> 7; t0 = (u & 127) * 16; mrow0 = s * SEQ; } else { const int v = u - 512; s = v >> 2; t0 = (v & 3) * 16; mrow0 = MP + s * DS; }
    bf16_t* ut = (bf16_t*)lds;
    float* cv = (float*)(lds + 46 * 2048);
    __syncthreads();
    for (int e = tid; e < 46 * 128; e += NTHR) { const int r = e >> 7, c8 = (e & 127) * 8, t = t0 - 30 + r;
        u32x4 w = {0u, 0u, 0u, 0u};
        if (t >= 0) w = *(const u32x4*)(U + (size_t)(mrow0 + t) * DC + c8);
        else if (!prompt) { const float* sp = A.in[I_SCONV] + (((size_t)l * DB + s) * 30 + (30 + t)) * DC + c8; w = pack8f(*(const f32x4*)sp, *(const f32x4*)(sp + 4)); }
        *(u32x4*)(ut + r * 1024 + c8) = w; }
    float w0[CW], w1[CW];
    const float* cw = A.in[I_CONVW] + (size_t)l * CW * DC + 2 * tid;
#pragma unroll
    for (int j = 0; j < CW; ++j) { const f32x2v w = *(const f32x2v*)(cw + (size_t)j * DC); w0[j] = w[0]; w1[j] = w[1]; }
    const f32x2v cbv = *(const f32x2v*)(A.in[I_CONVB] + l * DC + 2 * tid);
    __syncthreads();
#pragma unroll 1
    for (int sub = 0; sub < 2; ++sub) {
#pragma unroll 1
        for (int tt = 0; tt < 8; ++tt) {
            const int r0 = sub * 8 + tt; float a0 = cbv[0], a1 = cbv[1];
            const unsigned* up = (const unsigned*)(ut + r0 * 1024) + tid;
#pragma unroll
            for (int j = 0; j < CW; ++j) { const unsigned x = up[j * 512]; a0 += w0[j] * bf_lo(x); a1 += w1[j] * bf_hi(x); }
            *(f32x2v*)(cv + tt * 1024 + 2 * tid) = (f32x2v){a0, a1};
        }
        __syncthreads();
        {
            const int t = t0 + sub * 8 + wave; const size_t m = (size_t)mrow0 + t;
            const f32x4* c4 = (const f32x4*)(cv + wave * 1024) + lane;
            f32x4 x[4]; float sum = 0.f;
#pragma unroll
            for (int j = 0; j < 4; ++j) { x[j] = c4[64 * j]; sum += (x[j][0] + x[j][1]) + (x[j][2] + x[j][3]); }
            const float mean = wave_sum(sum) * (1.0f / DC); float sq = 0.f;
#pragma unroll
            for (int j = 0; j < 4; ++j) { x[j] = x[j] - mean; sq += (x[j][0] * x[j][0] + x[j][1] * x[j][1]) + (x[j][2] * x[j][2] + x[j][3] * x[j][3]); }
            const float rstd = __builtin_amdgcn_rsqf(wave_sum(sq) * (1.0f / DC) + EPS);
#pragma unroll
            for (int j = 0; j < 4; ++j) { const int c = 4 * lane + 256 * j;
                const f32x4 g4 = *(const f32x4*)(A.in[I_LNG] + l * DC + c), b4 = *(const f32x4*)(A.in[I_LNB] + l * DC + c);
                const u32x2 gb = *(const u32x2*)(GB + m * DC + c);
                f32x4 y = x[j] * rstd * g4 + b4;
#pragma unroll
                for (int i = 0; i < 4; ++i) y[i] *= fsigmoid(y[i]);
                y[0] *= bf_lo(gb.x); y[1] *= bf_hi(gb.x); y[2] *= bf_lo(gb.y); y[3] *= bf_hi(gb.y);
                u32x2 o; o.x = cvtpk(y[0], y[1]); o.y = cvtpk(y[2], y[3]);
                *(u32x2*)(YAB + m * 2048 + 1024 + c) = o; }
        }
        __syncthreads();
    }
}
__device__ __forceinline__ int q3_grab(unsigned* ctr, LAS unsigned* slot) {
#ifdef Q3_STATIC
    __syncthreads(); const int v_ = (int)slot[1]; __syncthreads(); if (threadIdx.x == 0) slot[1] = v_ + gridDim.x; __syncthreads(); return v_;
#endif
    __syncthreads();
    if (threadIdx.x == 0) slot[0] = __hip_atomic_fetch_add(ctr, 1u, __ATOMIC_RELAXED, __HIP_MEMORY_SCOPE_AGENT);
    __syncthreads();
    return (int)slot[0];
}
constexpr int Q3_PROMPT = NB * NH * 4, Q3_SAMPLE = DB * NH * 2, Q3_CONVCH = 1, Q3_CONV = 576 / Q3_CONVCH, Q3_TOTAL = Q3_PROMPT + Q3_SAMPLE + Q3_CONV;
constexpr int S_SPLIT = 32;
__device__ __forceinline__ void p3_mix(const Args& A, int l, char* lds, LAS unsigned* slot, unsigned* ctr) {
    unsigned char* ws = opaque_p(A.ws);
    const bf16_t* Q = (const bf16_t*)(ws + WS_Q); const bf16_t* Kb = (const bf16_t*)(ws + WS_K); const bf16_t* Vb = (const bf16_t*)(ws + WS_V);
    const bf16_t* GA = (const bf16_t*)(ws + WS_GA); bf16_t* YAB = (bf16_t*)(ws + WS_YAB);
#ifdef Q3_STATIC
    __syncthreads(); if (threadIdx.x == 0) slot[1] = (unsigned)opaque_s((int)blockIdx.x); __syncthreads();
#endif
#ifdef OLD_P3
    const int G_ = gridDim.x, wg_ = blockIdx.x, GP_ = G_ / 2;
    for (int item = (wg_ < GP_ ? wg_ : Q3_PROMPT + 2 * (wg_ - GP_)), k_ = 0; item < Q3_TOTAL; ++k_, item = (wg_ < GP_ ? Q3_PROMPT + Q3_SAMPLE + (wg_ + (k_ - 1) * GP_) : Q3_TOTAL)) {
        __syncthreads();
#else
#ifndef Q3_DUP
#define Q3_DUP 0
#endif
    constexpr int Q3_EXTRA = Q3_DUP == 1 ? Q3_PROMPT : Q3_DUP == 2 ? Q3_SAMPLE : Q3_DUP == 3 ? Q3_CONV : 0;
    for (int item_ = q3_grab(ctr, slot); item_ < Q3_TOTAL + Q3_EXTRA; item_ = q3_grab(ctr, slot)) {
        const int item = item_ < Q3_TOTAL ? item_ : (Q3_DUP == 1 ? item_ - Q3_TOTAL : Q3_DUP == 2 ? Q3_PROMPT + (item_ - Q3_TOTAL) : Q3_PROMPT + Q3_SAMPLE + (item_ - Q3_TOTAL));
#endif
        if (item < Q3_PROMPT) {
            const int bh = item >> 2, x = item & 3, b = bh >> 3, h = bh & 7;
            fill_bias_prompt(lds, A.out + O_FP + ((size_t)l * MP + (size_t)b * SEQ) * NH + h, (8 - x) * 256);
            const size_t base = (size_t)b * SEQ * 1024 + h * 128;
            fa::BlockRef<bf16_t> r0, r1;
            r0.K = Kb + base; r0.V = Vb + base; r0.K2 = r0.K; r0.V2 = r0.V; r0.nk1 = 1 << 30; r0.live = 256; r0.po = nullptr; r0.pml = nullptr; r0.jlo = 0;
            r1 = r0;
            r0.P0 = x * 256; r0.Q = Q + base + (size_t)r0.P0 * 1024; r0.G = GA + base + (size_t)r0.P0 * 1024; r0.O = YAB + ((size_t)b * SEQ + r0.P0) * 2048 + h * 128; r0.jhi = r0.P0 / 64 + 4;
            r1.P0 = (7 - x) * 256; r1.Q = Q + base + (size_t)r1.P0 * 1024; r1.G = GA + base + (size_t)r1.P0 * 1024; r1.O = YAB + ((size_t)b * SEQ + r1.P0) * 2048 + h * 128; r1.jhi = r1.P0 / 64 + 4;
            fa::Seam S;
            fa::attn_prime<bf16_t>(r0, lds, S);
#pragma unroll 1
            for (int pass = 0; pass < 2; ++pass) fa::attn_block<bf16_t, false>(pass ? r1 : r0, r1, lds, S);
        } else if (item < Q3_PROMPT + Q3_SAMPLE) {
            const int it = item - Q3_PROMPT, bh = it >> 1, half = it & 1, b = bh >> 3, h = bh & 7;
            fill_bias_sample(lds, (const float*)(ws + WS_FC) + (((size_t)l * DB + b) * NH + h) * PAST, A.out + O_FS + ((size_t)l * MS + (size_t)b * DS) * NH + h);
            fa::BlockRef<float> r;
            const size_t cbase = (((size_t)l * DB + b) * PAST) * 1024 + h * 128, nbase = ((size_t)l * MS + (size_t)b * DS) * 1024 + h * 128;
            r.K = A.in[I_CK] + cbase; r.V = A.in[I_CV] + cbase; r.K2 = A.out + O_KS + nbase; r.V2 = A.out + O_VS + nbase; r.nk1 = PAST;
            const size_t qb = ((size_t)MP + (size_t)b * DS) * 1024 + h * 128;
            r.Q = Q + qb; r.G = GA + qb; r.O = YAB + ((size_t)MP + (size_t)b * DS) * 2048 + h * 128; r.P0 = PAST; r.live = DS;
#ifdef T_NOSPLIT
            if (half) continue;
            r.jlo = 0; r.jhi = (PAST + DS) / 64; r.po = nullptr; r.pml = nullptr;
#else
            r.jlo = half ? S_SPLIT : 0; r.jhi = half ? (PAST + DS) / 64 : S_SPLIT;
            r.po = (float*)(ws + WS_PO) + ((size_t)bh * 2 + half) * DS * 128; r.pml = (float*)(ws + WS_PML) + ((size_t)bh * 2 + half) * DS * 2;
#endif
            fa::sample_item(r, lds);
        } else {
            const int c0 = (item - Q3_PROMPT - Q3_SAMPLE) * Q3_CONVCH;
#pragma unroll 1
            for (int u = c0; u < c0 + Q3_CONVCH; ++u) conv_unit(A, l, lds, u);
        }
    }
}
__device__ __forceinline__ void p3b_combine(const Args& A, int wg_, int G_) {
#ifdef T_NOSPLIT
    return;
#endif
    const int wg = opaque_s(wg_), G = opaque_s(G_);
    const int tid = opaque_tid(), lane = tid & 63, wave = __builtin_amdgcn_readfirstlane(tid >> 6);
    unsigned char* ws = opaque_p(A.ws);
    const float* PO = (const float*)(ws + WS_PO); const float* PML = (const float*)(ws + WS_PML);
    const bf16_t* GA = (const bf16_t*)(ws + WS_GA); bf16_t* YAB = (bf16_t*)(ws + WS_YAB);
    constexpr float C2 = 1.4426950408889634f * fa::SCALE;
    for (int u = wg * NWAVES + wave; u < DB * NH * DS; u += G * NWAVES) {
        const int bh = u >> 6, row = u & 63, b = bh >> 3, h = bh & 7;
        const float* ml = PML + (size_t)bh * 2 * DS * 2 + row * 2;
        const float m0 = ml[0], l0 = ml[1], m1 = ml[DS * 2], l1 = ml[DS * 2 + 1];
        const float M = fmaxf(m0, m1), w0 = __builtin_amdgcn_exp2f((m0 - M) * C2), w1 = __builtin_amdgcn_exp2f((m1 - M) * C2);
        const float inv = 1.0f / (w0 * l0 + w1 * l1);
        const f32x2v o0 = *(const f32x2v*)(PO + ((size_t)bh * 2 * DS + row) * 128 + 2 * lane), o1 = *(const f32x2v*)(PO + (((size_t)bh * 2 + 1) * DS + row) * 128 + 2 * lane);
        const size_t m = (size_t)MP + (size_t)b * DS + row;
        const unsigned g = *(const unsigned*)(GA + m * 1024 + h * 128 + 2 * lane);
        *(unsigned*)(YAB + m * 2048 + h * 128 + 2 * lane) = cvtpk((w0 * o0[0] + w1 * o1[0]) * inv * bf_lo(g), (w0 * o0[1] + w1 * o1[1]) * inv * bf_hi(g));
    }
}

constexpr int PPL = 6;
constexpr int N_PHASES = 1 + PPL * DEPTH;
__global__ void __launch_bounds__(NTHR, 2) fox_fwd(Args args) {
    extern __shared__ __attribute__((aligned(16))) unsigned char lds[];
    LAS unsigned char* L = (LAS unsigned char*)lds;
    volatile LAS unsigned* MISC = (volatile LAS unsigned*)(L + MISC_OFF);
    const int tid = threadIdx.x;
    const int G = gridDim.x, wg = blockIdx.x;
    if (tid < 32) MISC[tid] = 0u;
    __syncthreads();
    unsigned char* ws = args.ws;
    unsigned* ctl = (unsigned*)(ws + WS_CTL);
#if MK_ONE_LAUNCH
    constexpr int lo = 0, hi = N_PHASES;
#else
    const int lo = args.ph_lo, hi = args.ph_hi;
#endif
    XcdBarrier bar; bar.bar = ctl + CW_BAR; bar.x = 0; bar.st = nullptr;
    if (hi - lo > 1) bar = xcd_barrier_post(ctl + CW_BAR, MISC + 8);
#define IN(k) (lo <= (k) && (k) < hi)
#define SEAM(k) do { if (IN((k) + 1)) xcd_barrier(bar); } while (0)
#ifndef PHM
#define PHM 63
#endif
#ifndef REP_MASK
#define REP_MASK 0
#endif
#define REPS(bit, l) (((REP_MASK >> (bit)) & 1) && (l) == 0 ? 2 : 1)
    if ((PHM & 1) && IN(0)) { for (int rep = 0; rep < REPS(0, 0); ++rep) { p0_prologue(args, L, wg, G); SEAM(0); } }
    for (int l = 0; l < DEPTH; ++l) {
        const int pb = 1 + PPL * l;
        ws = opaque_p(args.ws);
        if ((PHM & 2) && IN(pb + 0)) { for (int rep = 0; rep < REPS(1, l); ++rep) { p1_norm(args, l, L, wg, G); SEAM(pb + 0); } }
        if ((PHM & 4) && IN(pb + 1)) { for (int rep = 0; rep < REPS(2, l); ++rep) {
            pg8::Gemm g{(const bf16_t*)(ws + WS_H), (const bf16_t*)(ws + WS_WIN) + (size_t)l * NIN * DM, MT, NIN, DM};
            pg8::StaticOrder S; S.init(MT, NIN, G, wg);
            EpiIn E{ws, args.out, l, args.in[I_QG] + l * HD, args.in[I_KG] + l * HD, (LAS float*)(L + XS_OFF)};
            pg8::gemm_phase<EpiIn, pg8::StaticOrder, true, true>(L, g, S, E);
            SEAM(pb + 1);
        } }
        if ((PHM & 8) && IN(pb + 2)) { p3_mix(args, l, (char*)lds, (LAS unsigned*)(MISC + 16), ctl + CW_Q3 + 64 * l); SEAM(pb + 2); }
        if ((PHM & 8) && IN(pb + 3)) { p3b_combine(args, wg, G); SEAM(pb + 3); }
        if ((PHM & 16) && IN(pb + 4)) { for (int rep = 0; rep < REPS(4, l); ++rep) {
            pg8::Gemm g{(const bf16_t*)(ws + WS_YAB), (const bf16_t*)(ws + WS_WOAB) + (size_t)l * DM * DM, MT, DM, DM};
            pg8::StaticOrder S; S.init(MT, DM, G, wg);
            EpiMerge E{(const bf16_t*)(ws + WS_SA), (const bf16_t*)(ws + WS_SB), (bf16_t*)(ws + WS_H)};
            pg8::gemm_phase<EpiMerge, pg8::StaticOrder, true, true>(L, g, S, E);
            SEAM(pb + 4);
        } }
        if ((PHM & 32) && IN(pb + 5)) { for (int rep = 0; rep < REPS(5, l); ++rep) {
            pg8::Gemm g{(const bf16_t*)(ws + WS_H), (const bf16_t*)(ws + WS_WOUT) + (size_t)l * DM * DM, MT, DM, DM};
            pg8::StaticOrder S; S.init(MT, DM, G, wg);
            EpiOut E{l == 0 ? args.in[I_XP] : args.out + O_YP, l == 0 ? args.in[I_XS] : args.out + O_YS, args.out, (const float*)(ws + WS_MOD) + (size_t)l * NSEQ * 6144 + 2 * DM};
            pg8::gemm_phase<EpiOut, pg8::StaticOrder, true, true>(L, g, S, E);
            SEAM(pb + 5);
        } }
    }
#undef IN
#undef SEAM
}

extern "C" void kernel_launch(void* const* d_in, const int* in_sizes, int n_in, void* d_out, int out_size, void* d_ws, size_t ws_size, hipStream_t stream) {
    static int grid = 0;
    if (grid == 0) {
        if (n_in != 22 || out_size != (int)O_END || ws_size < WS_END) { fprintf(stderr, "kernel_launch: unexpected shapes (n_in %d, out %d, ws %zu)\n", n_in, out_size, ws_size); grid = -1; return; }
        int dev = 0, cus = 0, per_cu = 0;
        if (hipGetDevice(&dev) != hipSuccess || hipDeviceGetAttribute(&cus, hipDeviceAttributeMultiprocessorCount, dev) != hipSuccess) { grid = -1; return; }
        if (hipFuncSetAttribute((const void*)fox_fwd, hipFuncAttributeMaxDynamicSharedMemorySize, LDS_BYTES) != hipSuccess) { fprintf(stderr, "kernel_launch: hipFuncSetAttribute failed\n"); grid = -1; return; }
        if (hipOccupancyMaxActiveBlocksPerMultiprocessor(&per_cu, (const void*)fox_fwd, NTHR, LDS_BYTES) != hipSuccess || per_cu < 1) { fprintf(stderr, "kernel_launch: occupancy query says %d\n", per_cu); (void)hipGetLastError(); }
        grid = cus;
    }
    if (grid < 0) return;
    (void)hipMemsetAsync((char*)d_ws + WS_CTL, 0, CTL_ZERO_BYTES, stream);
    Args a{};
    for (int i = 0; i < 22; ++i) a.in[i] = (const float*)d_in[i];
    a.out = (float*)d_out; a.ws = (unsigned char*)d_ws;
#if MK_ONE_LAUNCH
    a.ph_lo = 0; a.ph_hi = N_PHASES;
    hipLaunchKernelGGL(fox_fwd, dim3(grid), dim3(NTHR), LDS_BYTES, stream, a);
#else
    for (int p = 0; p < N_PHASES; ++p) { a.ph_lo = p; a.ph_hi = p + 1; hipLaunchKernelGGL(fox_fwd, dim3(grid), dim3(NTHR), LDS_BYTES, stream, a); }
#endif
}
```

```cpp
#include <hip/hip_runtime.h>
#include <cstdio>
#include <cstdint>
#ifndef MK_ONE_LAUNCH
#define MK_ONE_LAUNCH 1
#endif
__device__ __forceinline__ int opaque_tid() { int t = threadIdx.x; asm volatile("" : "+v"(t)); return t; }
#ifdef NO_LAUNDER_S
template <class T> __device__ __forceinline__ T* opaque_p(T* p) { return p; }
__device__ __forceinline__ int opaque_s(int v) { return v; }
#else
template <class T> __device__ __forceinline__ T* opaque_p(T* p) { __attribute__((address_space(1))) T* q = (__attribute__((address_space(1))) T*)p; asm volatile("" : "+s"(q)); return (T*)q; }
__device__ __forceinline__ int opaque_s(int v) { asm volatile("" : "+s"(v)); return v; }
#endif
namespace pg8 {
#define PG8_LAS __attribute__((address_space(3)))
typedef unsigned short bf16_t;
typedef short bf16x8 __attribute__((ext_vector_type(8)));
typedef float f32x4 __attribute__((ext_vector_type(4)));
typedef unsigned u32x4 __attribute__((ext_vector_type(4)));
constexpr int BM = 256, BK = 64, HALF = 128, HTB = HALF * BK * 2  , STAGE_BYTES = 8 * HTB, NXCD = 8, WGM = 8;

__host__ __device__ __forceinline__ int lds_byte(int r, int c) { const int st = (r >> 4) * 2 + (c >> 5), rr = r & 15, cc = c & 31, ob = rr * 64 + cc * 2; return st * 1024 + (ob ^ (((ob >> 9) & 1) << 5)); }
__host__ __device__ __forceinline__ void stage_rc(int b, int& R, int& C) { const int st = b / 1024, sb = b % 1024, swz = sb ^ (((sb >> 9) & 1) << 5); R = (st >> 1) * 16 + swz / 64; C = (st & 1) * 32 + (swz % 64) / 2; }
__host__ __device__ __forceinline__ int perm32(int rho) { const int n = rho >> 4, i = rho & 15; return 8 * (i >> 2) + 4 * n + (i & 3); }

struct Unit { int pm, pn, half;
    __host__ __device__ __forceinline__ int row0() const { return pm * 256 + (half == 1 ? 128 : 0); } __host__ __device__ __forceinline__ int nai() const { return half < 0 ? 2 : 1; } };
struct Gemm { const bf16_t* A; const bf16_t* Bt; int M, N, K; };

struct StaticOrder {
    int nM, nN, nwg, G, c;
    __host__ __device__ void init(int M, int N, int G_, int c_) { nM = M / BM; nN = N / BM; nwg = nM * nN; G = G_; c = c_; }
    __host__ __device__ bool next(int i, Unit& u) const {
        const int R = nwg / G, nfull = R * G, left = nwg - nfull; long L; u.half = -1;
        if (i < R) L = (long)i * G + c;
        else if (i == R && left > 0) {
            if (2 * left <= G) { if (c >= 2 * left) return false; L = nfull + (c >> 1); u.half = c & 1; }
            else { if (c >= left) return false; L = nfull + c; }
        } else return false;
        int wgid = (int)L; { const int q = nwg / NXCD, r = nwg % NXCD, xcd = wgid % NXCD, off = wgid / NXCD; wgid = (xcd < r ? xcd * (q + 1) : r * (q + 1) + (xcd - r) * q) + off; }
        const int nig = WGM * nN, gid = wgid / nig, fm = gid * WGM, gsz = (nM - fm) < WGM ? (nM - fm) : WGM;
        u.pm = fm + ((wgid % nig) % gsz); u.pn = (wgid % nig) / gsz; return true;
    }
    __device__ __forceinline__ void a_ready(const Unit&) const {}
    __device__ __forceinline__ void done(const Unit&) const {}
};

__device__ __forceinline__ unsigned cvt_pk_bf16(float lo, float hi) { unsigned r; asm volatile("v_cvt_pk_bf16_f32 %0, %1, %2" : "=v"(r) : "v"(lo), "v"(hi)); return r; }
typedef float f32x2 __attribute__((ext_vector_type(2)));
template <class Epi, class Sched, bool ALIGN_EPI = false, bool SP2 = false>
__device__ __forceinline__ void gemm_phase(PG8_LAS unsigned char* lds, const Gemm g, const Sched& S, const Epi& E) {
    const int tid = opaque_tid(), wid = __builtin_amdgcn_readfirstlane(tid >> 6), lane = tid & 63, wr = wid >> 2, wc = wid & 3, fr = lane & 15, fq = lane >> 4;
    const int K = g.K, nt = K / BK;
    unsigned voffA[2], voffB[2];
#pragma unroll
    for (int i = 0; i < 2; ++i) { int R, C; stage_rc(tid * 16 + i * 8192, R, C); const int Rb = Epi::PERM ? ((R & ~31) + perm32(R & 31)) : R;
        voffA[i] = (unsigned)(R * K + C) * 2u; voffB[i] = (unsigned)(Rb * K + C) * 2u; }
    const size_t kstep = (size_t)(BK * 2);
    const size_t hstep = (size_t)HALF * K * 2;
    const size_t tstep = 2 * hstep;
    const unsigned ldsw = (unsigned)wid * 1024u;
    const int aoff = lds_byte(wr * 64 + fr, fq * 8), boff = lds_byte(wc * 32 + fr, fq * 8);
#define PG8_SA(b, h) (((b) * 2 + (h)) * HTB)
#define PG8_SB(b, h) ((4 + (b) * 2 + (h)) * HTB)
#define PG8_STAGE(bufoff, gbase, voff) do { _Pragma("unroll") for (int _i = 0; _i < 2; ++_i) \
        __builtin_amdgcn_global_load_lds((const unsigned*)((const char*)(gbase) + (voff)[_i]), (PG8_LAS unsigned*)(lds + (bufoff) + ldsw + _i * 8192), 16, 0, 0); } while (0)
#define PG8_LDA(dst, b, h) do { _Pragma("unroll") for (int m = 0; m < 4; ++m) _Pragma("unroll") for (int k = 0; k < 2; ++k) dst[m][k] = *(const PG8_LAS bf16x8*)(lds + PG8_SA(b, h) + aoff + m * 2048 + k * 1024); } while (0)
#define PG8_LDB(dst, b, h) do { _Pragma("unroll") for (int n = 0; n < 2; ++n) _Pragma("unroll") for (int k = 0; k < 2; ++k) dst[n][k] = *(const PG8_LAS bf16x8*)(lds + PG8_SB(b, h) + boff + n * 2048 + k * 1024); } while (0)
#define PG8_MMA(ai, bj, At, Bt) do { __builtin_amdgcn_s_setprio(1); _Pragma("unroll") for (int m = 0; m < 4; ++m) _Pragma("unroll") for (int n = 0; n < 2; ++n) _Pragma("unroll") for (int k = 0; k < 2; ++k) \
        acc[ai][bj][m][n] = __builtin_amdgcn_mfma_f32_16x16x32_bf16(Bt[n][k], At[m][k], acc[ai][bj][m][n], 0, 0, 0); __builtin_amdgcn_s_setprio(0); } while (0)
#define PG8_WAIT_V(n) asm volatile("s_waitcnt vmcnt(" #n ")" ::: "memory")
#define PG8_WAIT_L(n) asm volatile("s_waitcnt lgkmcnt(" #n ")" ::: "memory")
#define PG8_BAR __builtin_amdgcn_s_barrier()
#define PG8_SCHED __builtin_amdgcn_sched_barrier(0)
    Unit cur, nxt; int ui = 0;
    if (!S.next(0, cur)) return;
    f32x4 acc[2][2][4][2];
#pragma unroll
    for (int a = 0; a < 2; ++a)
#pragma unroll
        for (int b = 0; b < 2; ++b)
#pragma unroll
            for (int m = 0; m < 4; ++m)
#pragma unroll
                for (int n = 0; n < 2; ++n) acc[a][b][m][n] = (f32x4){0.f, 0.f, 0.f, 0.f};
    bf16x8 At[4][2], B0[2][2], B1[2][2];
    const char* cA = (const char*)g.A + (size_t)cur.pm * tstep + (cur.half == 1 ? hstep : 0); const char* cB = (const char*)g.Bt + (size_t)cur.pn * tstep;
    S.a_ready(cur);
    if constexpr (SP2) {
        PG8_STAGE(PG8_SB(0, 0), cB, voffB); PG8_STAGE(PG8_SB(0, 1), cB + hstep, voffB); PG8_STAGE(PG8_SA(0, 0), cA, voffA); PG8_STAGE(PG8_SA(0, 1), cA + hstep, voffA);
        if (wr == 1) PG8_BAR;
        PG8_WAIT_V(2); PG8_BAR;
        PG8_STAGE(PG8_SB(1, 0), cB + kstep, voffB); PG8_STAGE(PG8_SA(1, 0), cA + kstep, voffA); PG8_STAGE(PG8_SB(1, 1), cB + hstep + kstep, voffB);
        PG8_WAIT_V(6); PG8_BAR;
    } else {
        PG8_STAGE(PG8_SB(0, 0), cB, voffB); PG8_STAGE(PG8_SA(0, 0), cA, voffA); PG8_STAGE(PG8_SB(0, 1), cB + hstep, voffB); PG8_STAGE(PG8_SA(0, 1), cA + hstep, voffA);
        if (wr == 1) PG8_BAR;
        PG8_WAIT_V(4); PG8_BAR;
        PG8_STAGE(PG8_SB(1, 0), cB + kstep, voffB); PG8_STAGE(PG8_SA(1, 0), cA + kstep, voffA); PG8_STAGE(PG8_SB(1, 1), cB + hstep + kstep, voffB);
        PG8_WAIT_V(6); PG8_BAR;
    }
    for (;;) {
        const bool has_next = S.next(ui + 1, nxt);
        const char* nA = has_next ? (const char*)g.A + (size_t)nxt.pm * tstep + (nxt.half == 1 ? hstep : 0) : cA; const char* nB = has_next ? (const char*)g.Bt + (size_t)nxt.pn * tstep : cB;
        for (int t = 0; t < nt; t += 2) {
            if constexpr (Epi::HAS_MID) { if (t == (nt >> 1)) { E.mid(acc, cur, wr, wc, fr, fq); PG8_SCHED; } }
            const bool last = (t == nt - 2);
            const char* a1 = cA + (size_t)(t + 1) * kstep;
            const char* a2 = last ? nA : cA + (size_t)(t + 2) * kstep; const char* b2 = last ? nB : cB + (size_t)(t + 2) * kstep;
            const char* a3 = a2 + kstep; const char* b3 = b2 + kstep;
            if (last && has_next) S.a_ready(nxt);
            if constexpr (SP2) {
            PG8_LDB(B0, 0, 0); PG8_LDB(B1, 0, 1); PG8_SCHED; PG8_LDA(At, 0, 0); PG8_STAGE(PG8_SA(1, 1), a1 + hstep, voffA);
            PG8_WAIT_V(8); PG8_WAIT_L(0); PG8_BAR; PG8_MMA(0, 0, At, B0); PG8_MMA(0, 1, At, B1); PG8_BAR; PG8_SCHED;
            PG8_LDA(At, 0, 1); PG8_STAGE(PG8_SB(0, 0), b2, voffB); PG8_STAGE(PG8_SB(0, 1), b2 + hstep, voffB); PG8_STAGE(PG8_SA(0, 0), a2, voffA);
            PG8_WAIT_V(8); PG8_WAIT_L(0); PG8_BAR; if (cur.half < 0) { PG8_MMA(1, 0, At, B0); PG8_MMA(1, 1, At, B1); } PG8_BAR; PG8_SCHED;
            PG8_LDB(B0, 1, 0); PG8_LDB(B1, 1, 1); PG8_SCHED; PG8_LDA(At, 1, 0); PG8_STAGE(PG8_SA(0, 1), a2 + hstep, voffA);
            PG8_WAIT_V(8); PG8_WAIT_L(0); PG8_BAR; PG8_MMA(0, 0, At, B0); PG8_MMA(0, 1, At, B1); PG8_BAR; PG8_SCHED;
            PG8_LDA(At, 1, 1); PG8_STAGE(PG8_SB(1, 0), b3, voffB); PG8_STAGE(PG8_SB(1, 1), b3 + hstep, voffB); PG8_STAGE(PG8_SA(1, 0), a3, voffA);
            PG8_WAIT_V(8); PG8_WAIT_L(0); PG8_BAR; if (cur.half < 0) { PG8_MMA(1, 0, At, B0); PG8_MMA(1, 1, At, B1); } PG8_BAR; PG8_SCHED;
            } else {
            PG8_LDB(B0, 0, 0); PG8_SCHED; PG8_LDA(At, 0, 0); PG8_STAGE(PG8_SA(1, 1), a1 + hstep, voffA);
            PG8_WAIT_L(8); PG8_BAR; PG8_WAIT_L(0); PG8_MMA(0, 0, At, B0); PG8_BAR; PG8_SCHED;
            PG8_LDB(B1, 0, 1); PG8_STAGE(PG8_SB(0, 0), b2, voffB);
            PG8_BAR; PG8_WAIT_L(0); PG8_MMA(0, 1, At, B1); PG8_BAR;
            PG8_LDA(At, 0, 1); PG8_STAGE(PG8_SA(0, 0), a2, voffA);
            PG8_BAR; PG8_WAIT_L(0); PG8_MMA(1, 0, At, B0); PG8_BAR; PG8_SCHED;
            PG8_STAGE(PG8_SB(0, 1), b2 + hstep, voffB);
            PG8_WAIT_V(6); PG8_BAR; PG8_MMA(1, 1, At, B1); PG8_BAR;
            PG8_LDB(B0, 1, 0); PG8_SCHED; PG8_LDA(At, 1, 0); PG8_STAGE(PG8_SA(0, 1), a2 + hstep, voffA);
            PG8_WAIT_L(8); PG8_BAR; PG8_WAIT_L(0); PG8_MMA(0, 0, At, B0); PG8_BAR; PG8_SCHED;
            PG8_LDB(B1, 1, 1); PG8_STAGE(PG8_SB(1, 0), b3, voffB);
            PG8_BAR; PG8_WAIT_L(0); PG8_MMA(0, 1, At, B1); PG8_BAR;
            PG8_LDA(At, 1, 1); PG8_STAGE(PG8_SA(1, 0), a3, voffA);
            PG8_BAR; PG8_WAIT_L(0); PG8_MMA(1, 0, At, B0); PG8_BAR; PG8_SCHED;
            PG8_STAGE(PG8_SB(1, 1), b3 + hstep, voffB);
            PG8_WAIT_V(6); PG8_BAR; PG8_MMA(1, 1, At, B1); PG8_BAR;
            }
        }
        if constexpr (ALIGN_EPI) { if (wr == 0) PG8_BAR; }
        if constexpr (!Epi::AFTER_DRAIN) { E(acc, cur, wr, wc, fr, fq); S.done(cur); }
        if (!has_next) break;
#pragma unroll
        for (int a = 0; a < 2; ++a)
#pragma unroll
            for (int b = 0; b < 2; ++b)
#pragma unroll
                for (int m = 0; m < 4; ++m)
#pragma unroll
                    for (int n = 0; n < 2; ++n) acc[a][b][m][n] = (f32x4){0.f, 0.f, 0.f, 0.f};
        cur = nxt; cA = nA; cB = nB; ++ui;
        if constexpr (ALIGN_EPI) { if (wr == 1) PG8_BAR; }
    }
    PG8_WAIT_V(0);
    if constexpr (!ALIGN_EPI) { if (wr == 0) PG8_BAR; }
    PG8_BAR;
    if constexpr (Epi::AFTER_DRAIN) { E.fused(acc, cur, wr, wc, fr, fq, lds, wid, lane); S.done(cur); }
#undef PG8_SA
#undef PG8_SB
#undef PG8_STAGE
#undef PG8_LDA
#undef PG8_LDB
#undef PG8_MMA
#undef PG8_WAIT_V
#undef PG8_WAIT_L
#undef PG8_BAR
#undef PG8_SCHED
}
}

using pg8::bf16_t; using pg8::bf16x8; using pg8::f32x4; using pg8::u32x4; using pg8::Unit;
typedef float f32x16 __attribute__((ext_vector_type(16)));
typedef float f32x2v __attribute__((ext_vector_type(2)));
typedef short s16x4 __attribute__((ext_vector_type(4)));
typedef unsigned u32x2 __attribute__((ext_vector_type(2)));
#define LAS __attribute__((address_space(3)))
#define GAS __attribute__((address_space(1)))

constexpr int DM = 2048, NB = 4, SEQ = 2048, DEPTH = 2, DB = 16, DS = 64, PAST = 4096;
constexpr int NH = 8, HD = 128, DA = 1024, DC = 1024, CW = 31, DIN = 11272, NIN = 11264;
constexpr int MP = NB * SEQ, MS = DB * DS, MT = MP + MS, NSEQ = NB + DB;
constexpr float EPS = 1e-6f;
constexpr int NWAVES = 8, NTHR = 512;
constexpr size_t O_YP = 0, O_YS = 16777216, O_KP = 18874368, O_VP = 35651584, O_FP = 52428800, O_CP = 52559872,
                 O_KS = 52805632, O_VS = 54902784, O_FS = 56999936, O_CS = 57016320, O_END = 57999360;
constexpr size_t MiB = 1u << 20;
constexpr size_t WS_CTL = 0, CTL_ZERO_BYTES = 1 * MiB;
constexpr size_t WS_WF = 1 * MiB;
constexpr size_t WS_MOD = 2 * MiB;
constexpr size_t WS_FC = 4 * MiB;
constexpr size_t WS_WIN = 8 * MiB;
constexpr size_t WS_WOAB = 96 * MiB;
constexpr size_t WS_WOUT = 112 * MiB;
constexpr size_t WS_H = 128 * MiB;
constexpr size_t WS_Q = 164 * MiB, WS_K = 183 * MiB, WS_V = 202 * MiB;
constexpr size_t WS_GA = 221 * MiB, WS_U = 239 * MiB, WS_GB = 257 * MiB;
constexpr size_t WS_SA = 275 * MiB, WS_SB = 311 * MiB;
constexpr size_t WS_YAB = 347 * MiB;
constexpr size_t WS_PO = 383 * MiB;
constexpr size_t WS_PML = 391 * MiB;
constexpr size_t WS_END = 392 * MiB;
constexpr int CW_BAR = 4096;
constexpr int CW_Q3 = 8192;
constexpr int CW_Q0 = 8192 + 256;
constexpr int RING_BYTES = 131072;
constexpr int XS_OFF = RING_BYTES;
constexpr int LDS_BYTES = 163840;
constexpr int MISC_OFF = LDS_BYTES - 256;

__device__ __forceinline__ float dpp_add(float v, int ctrl_sel) {
    int r;
    if (ctrl_sel == 0) r = __builtin_amdgcn_update_dpp(0, __float_as_int(v), 0xB1, 0xF, 0xF, true);
    else if (ctrl_sel == 1) r = __builtin_amdgcn_update_dpp(0, __float_as_int(v), 0x4E, 0xF, 0xF, true);
    else if (ctrl_sel == 2) r = __builtin_amdgcn_update_dpp(0, __float_as_int(v), 0x141, 0xF, 0xF, true);
    else r = __builtin_amdgcn_update_dpp(0, __float_as_int(v), 0x140, 0xF, 0xF, true);
    return v + __int_as_float(r);
}
__device__ __forceinline__ float wave_sum(float v) {
    v = dpp_add(v, 0); v = dpp_add(v, 1); v = dpp_add(v, 2); v = dpp_add(v, 3);
    { auto rr = __builtin_amdgcn_permlane16_swap(__float_as_uint(v), __float_as_uint(v), false, false); v = __uint_as_float(rr[0]) + __uint_as_float(rr[1]); }
    { auto rr = __builtin_amdgcn_permlane32_swap(__float_as_uint(v), __float_as_uint(v), false, false); v = __uint_as_float(rr[0]) + __uint_as_float(rr[1]); }
    return v;
}
__device__ __forceinline__ unsigned cvtpk(float lo, float hi) { unsigned r; asm volatile("v_cvt_pk_bf16_f32 %0, %1, %2" : "=v"(r) : "v"(lo), "v"(hi)); return r; }
__device__ __forceinline__ float bf_lo(unsigned u) { return __uint_as_float(u << 16); }
__device__ __forceinline__ float bf_hi(unsigned u) { return __uint_as_float(u & 0xffff0000u); }
__device__ __forceinline__ float fsigmoid(float x) { return __builtin_amdgcn_rcpf(1.0f + __builtin_amdgcn_exp2f(-1.4426950408889634f * x)); }
__device__ __forceinline__ u32x4 pack8f(f32x4 a, f32x4 b) { u32x4 w = {cvtpk(a[0], a[1]), cvtpk(a[2], a[3]), cvtpk(b[0], b[1]), cvtpk(b[2], b[3])}; return w; }
__device__ __forceinline__ int seq_of_row(int m) { return m < MP ? (m >> 11) : NB + ((m - MP) >> 6); }

struct EpiIn {
    static constexpr bool PERM = true, AFTER_DRAIN = false, HAS_MID = false;
    unsigned char* ws; float* out; int layer; const float *qg, *kg; LAS float* xs;
    __device__ __forceinline__ void st8(bf16_t* p, f32x4 a, f32x4 b) const { *(u32x4*)p = pack8f(a, b); }
    __device__ __forceinline__ void operator()(const f32x4 (&acc)[2][2][4][2], const Unit& u, int wr, int wc, int fr, int fq) const {
        const int pn = u.pn, cw = wc * 32 + 8 * fq, nai = u.nai();
        const int rbase = u.row0() + wr * 64 + fr;
        const bool prompt = u.pm < 32;
        if (pn < 8) {
            const bool isk = pn >= 4; const int hp = (pn & 3) * 2;
#pragma unroll
            for (int ai = 0; ai < 2; ++ai) if (ai < nai)
#pragma unroll
                for (int m = 0; m < 4; ++m)
#pragma unroll
                    for (int bj = 0; bj < 2; ++bj) {
                        const f32x4 a = acc[ai][bj][m][0], b = acc[ai][bj][m][1];
                        float s = (a[0] * a[0] + a[1] * a[1]) + (a[2] * a[2] + a[3] * a[3]) + (b[0] * b[0] + b[1] * b[1]) + (b[2] * b[2] + b[3] * b[3]);
                        s += __shfl_xor(s, 16); s += __shfl_xor(s, 32);
                        if (fq == 0) xs[((wr * 4 + wc) * 128 + ai * 64 + m * 16 + fr) * 2 + bj] = s;
                    }
            asm volatile("s_waitcnt lgkmcnt(0)" ::: "memory"); __builtin_amdgcn_s_barrier(); asm volatile("" ::: "memory");
            const float* g = isk ? kg : qg; const f32x4 g0 = *(const f32x4*)(g + cw), g1 = *(const f32x4*)(g + cw + 4);
            bf16_t* dst = (bf16_t*)(ws + (isk ? WS_K : WS_Q));
            float* fo = prompt ? out + O_KP + (size_t)layer * (MP * 1024) : out + O_KS + (size_t)layer * (MS * 1024) - (size_t)MP * 1024;
#pragma unroll
            for (int ai = 0; ai < 2; ++ai) if (ai < nai)
#pragma unroll
                for (int m = 0; m < 4; ++m) {
                    const int row = rbase + ai * 128 + m * 16;
#pragma unroll
                    for (int bj = 0; bj < 2; ++bj) {
                        const int xi = (wr * 4 * 128 + ai * 64 + m * 16 + fr) * 2 + bj;
                        const float tot = (xs[xi] + xs[xi + 256]) + (xs[xi + 512] + xs[xi + 768]);
                        const float rstd = __builtin_amdgcn_rsqf(tot * (1.0f / 128.0f) + EPS);
                        const f32x4 a = acc[ai][bj][m][0] * rstd * g0, b = acc[ai][bj][m][1] * rstd * g1;
                        const size_t o = (size_t)row * 1024 + (hp + bj) * 128 + cw;
                        st8(dst + o, a, b);
                        if (isk) { *(f32x4*)(fo + o) = a; *(f32x4*)(fo + o + 4) = b; }
                    }
                }
        } else if (pn < 12) {
            float* fo = prompt ? out + O_VP + (size_t)layer * (MP * 1024) : out + O_VS + (size_t)layer * (MS * 1024) - (size_t)MP * 1024;
#pragma unroll
            for (int ai = 0; ai < 2; ++ai) if (ai < nai)
#pragma unroll
                for (int m = 0; m < 4; ++m) {
                    const int row = rbase + ai * 128 + m * 16;
#pragma unroll
                    for (int bj = 0; bj < 2; ++bj) {
                        const f32x4 a = acc[ai][bj][m][0], b = acc[ai][bj][m][1];
                        const size_t o = (size_t)row * 1024 + (pn - 8) * 256 + bj * 128 + cw;
                        st8((bf16_t*)(ws + WS_V) + o, a, b); *(f32x4*)(fo + o) = a; *(f32x4*)(fo + o + 4) = b;
                    }
                }
        } else if (pn >= 16 && pn < 24) {
#pragma unroll
            for (int ai = 0; ai < 2; ++ai) if (ai < nai)
#pragma unroll
                for (int m = 0; m < 4; ++m) {
                    const int row = rbase + ai * 128 + m * 16;
                    f32x4 a = acc[ai][0][m][0], b = acc[ai][0][m][1]; const f32x4 ga = acc[ai][1][m][0], gb = acc[ai][1][m][1];
#pragma unroll
                    for (int i = 0; i < 4; ++i) { a[i] *= fsigmoid(ga[i]); b[i] *= fsigmoid(gb[i]); }
                    const int ch = (pn - 16) * 128 + cw;
                    st8((bf16_t*)(ws + WS_U) + (size_t)row * 1024 + ch, a, b);
                    int tl, sb; float* co;
                    if (prompt) { tl = (row & 2047) - (SEQ - 30); sb = row >> 11; co = out + O_CP + (size_t)layer * (NB * 30 * 1024); }
                    else { const int r2 = row - MP; tl = (r2 & 63) - (DS - 30); sb = r2 >> 6; co = out + O_CS + (size_t)layer * (DB * 30 * 1024); }
                    if (tl >= 0) { float* p = co + ((size_t)sb * 30 + tl) * 1024 + ch; *(f32x4*)p = a; *(f32x4*)(p + 4) = b; }
                }
        } else {
            const bool gate = pn >= 28;
            size_t woff; int ld, c0;
            if (pn < 16) { woff = WS_GA; ld = 1024; c0 = (pn - 12) * 256; }
            else if (pn < 28) { woff = WS_GB; ld = 1024; c0 = (pn - 24) * 256; }
            else if (pn < 36) { woff = WS_SA; ld = 2048; c0 = (pn - 28) * 256; }
            else { woff = WS_SB; ld = 2048; c0 = (pn - 36) * 256; }
            bf16_t* dst = (bf16_t*)(ws + woff);
#pragma unroll
            for (int ai = 0; ai < 2; ++ai) if (ai < nai)
#pragma unroll
                for (int m = 0; m < 4; ++m) {
                    const int row = rbase + ai * 128 + m * 16;
#pragma unroll
                    for (int bj = 0; bj < 2; ++bj) {
                        f32x4 a = acc[ai][bj][m][0], b = acc[ai][bj][m][1];
#pragma unroll
                        for (int i = 0; i < 4; ++i) { const float sa = fsigmoid(a[i]), sb = fsigmoid(b[i]); a[i] = gate ? sa : a[i] * sa; b[i] = gate ? sb : b[i] * sb; }
                        st8(dst + (size_t)row * ld + c0 + bj * 128 + cw, a, b);
                    }
                }
        }
    }
};
#ifndef MIDG
#define MIDG 4
#endif
struct EpiMerge {
    static constexpr bool PERM = true, AFTER_DRAIN = false, HAS_MID = true;
    const bf16_t *SA, *SB; bf16_t* MG;
    __device__ __forceinline__ void mid(f32x4 (&acc)[2][2][4][2], const Unit& u, int wr, int wc, int fr, int fq) const {
        int fr_ = fr; asm volatile("" : "+v"(fr_));
        const unsigned voff = (unsigned)(((wr * 64 + fr_) * 2048 + wc * 32 + 8 * fq) * 2);
        const size_t uoff = ((size_t)u.row0() * 2048 + (size_t)u.pn * 256) * 2; const int nai = u.nai();
        const bf16_t* pa = (const bf16_t*)((const char*)SA + uoff + voff); const bf16_t* pb = (const bf16_t*)((const char*)SB + uoff + voff);
#pragma unroll
        for (int ai = 0; ai < 2; ++ai) if (ai < nai)
#pragma unroll
            for (int mp = 0; mp < 4; mp += MIDG) {
                u32x4 sa[MIDG][2], sb[MIDG][2];
#pragma unroll
                for (int q = 0; q < MIDG; ++q)
#pragma unroll
                    for (int bj = 0; bj < 2; ++bj) { const size_t o = (size_t)(ai * 128 + (mp + q) * 16) * 2048 + bj * 128; sa[q][bj] = *(const u32x4*)(pa + o); sb[q][bj] = *(const u32x4*)(pb + o); }
#pragma unroll
                for (int q = 0; q < MIDG; ++q)
#pragma unroll
                    for (int bj = 0; bj < 2; ++bj)
#pragma unroll
                        for (int j = 0; j < 4; ++j) {
                            const float r0 = bf_lo(sa[q][bj][j]) * __builtin_amdgcn_rcpf(bf_lo(sb[q][bj][j])), r1 = bf_hi(sa[q][bj][j]) * __builtin_amdgcn_rcpf(bf_hi(sb[q][bj][j]));
                            acc[ai][bj][mp + q][j >> 1][(j & 1) * 2] *= r0; acc[ai][bj][mp + q][j >> 1][(j & 1) * 2 + 1] *= r1;
                        }
#pragma unroll
                for (int q = 0; q < MIDG; ++q) asm volatile("" : "+v"(acc[ai][0][mp + q][0]), "+v"(acc[ai][0][mp + q][1]), "+v"(acc[ai][1][mp + q][0]), "+v"(acc[ai][1][mp + q][1]));
                asm volatile("" ::: "memory");
            }
    }
    __device__ __forceinline__ void operator()(const f32x4 (&acc)[2][2][4][2], const Unit& u, int wr, int wc, int fr, int fq) const {
        const int cw = wc * 32 + 8 * fq, rbase = u.row0() + wr * 64 + fr, nai = u.nai();
#pragma unroll
        for (int ai = 0; ai < 2; ++ai) if (ai < nai)
#pragma unroll
            for (int m = 0; m < 4; ++m) {
                const int row = rbase + ai * 128 + m * 16;
#pragma unroll
                for (int bj = 0; bj < 2; ++bj) {
                    const size_t o = (size_t)row * 2048 + u.pn * 256 + bj * 128 + cw;
                    const u32x4 sb = *(const u32x4*)(SB + o);
                    f32x4 a = acc[ai][bj][m][0], b = acc[ai][bj][m][1];
                    a[0] *= bf_lo(sb[0]); a[1] *= bf_hi(sb[0]); a[2] *= bf_lo(sb[1]); a[3] *= bf_hi(sb[1]);
                    b[0] *= bf_lo(sb[2]); b[1] *= bf_hi(sb[2]); b[2] *= bf_lo(sb[3]); b[3] *= bf_hi(sb[3]);
                    *(u32x4*)(MG + o) = pack8f(a, b);
                }
                if (m & 1) asm volatile("" ::: "memory");
            }
    }
};
struct EpiOut {
    static constexpr bool PERM = false, AFTER_DRAIN = false, HAS_MID = false;
    const float* xp; const float* xsm; float* y; const float* gate;
    __device__ __forceinline__ void operator()(const f32x4 (&acc)[2][2][4][2], const Unit& u, int wr, int wc, int fr, int fq) const {
        const int rbase = u.row0() + wr * 64 + fr, col0 = u.pn * 256 + wc * 32 + 4 * fq, nai = u.nai();
#pragma unroll
        for (int ai = 0; ai < 2; ++ai) if (ai < nai) {
            const int s = seq_of_row(u.row0() + ai * 128 + wr * 64);
            f32x4 g[2][2];
#pragma unroll
            for (int bj = 0; bj < 2; ++bj)
#pragma unroll
                for (int n = 0; n < 2; ++n) g[bj][n] = *(const f32x4*)(gate + (size_t)s * 6144 + col0 + bj * 128 + n * 16);
            f32x4 xv[4][2][2];
#pragma unroll
            for (int m = 0; m < 4; ++m) {
                const int row = rbase + ai * 128 + m * 16;
                const float* xr = (row < MP) ? xp + (size_t)row * DM : xsm + (size_t)(row - MP) * DM;
#pragma unroll
                for (int bj = 0; bj < 2; ++bj)
#pragma unroll
                    for (int n = 0; n < 2; ++n) xv[m][bj][n] = *(const f32x4*)(xr + col0 + bj * 128 + n * 16);
            }
#pragma unroll
            for (int m = 0; m < 4; ++m) {
                float* yr = y + (size_t)(rbase + ai * 128 + m * 16) * DM;
#pragma unroll
                for (int bj = 0; bj < 2; ++bj)
#pragma unroll
                    for (int n = 0; n < 2; ++n) *(f32x4*)(yr + col0 + bj * 128 + n * 16) = xv[m][bj][n] + g[bj][n] * acc[ai][bj][m][n];
            }
            asm volatile("" ::: "memory");
        }
    }
};
#define XB_TMO      128
#define XB_XCNT(j)  (256  + 64 * (j))
#define XB_XSUB(j)  (1280 + 64 * (j))
#define XB_XGEN(j)  (2304 + 64 * (j))
#define XB_TOP      3328
#define XB_TOPGEN   3392
#define XCD_BAR_WORDS 3456
#define XB_SPIN_CAP (1u << 18)

__device__ __forceinline__ unsigned xb_ld(unsigned* p)              { return __hip_atomic_load(p, __ATOMIC_RELAXED, __HIP_MEMORY_SCOPE_AGENT); }
__device__ __forceinline__ unsigned xb_add(unsigned* p, unsigned v) { return __hip_atomic_fetch_add(p, v, __ATOMIC_RELAXED, __HIP_MEMORY_SCOPE_AGENT); }
__device__ __forceinline__ unsigned xb_xcc_id() { return (unsigned)__builtin_amdgcn_s_getreg((3 << 11) | 20) & 0xFu; }
#define XB_SPIN(cond, bar) do { unsigned _sp = 0; while (cond) { __builtin_amdgcn_s_sleep(1); \
    if ((++_sp & 255u) == 0u) { if (xb_ld(&(bar)[XB_TMO])) break; if (_sp > XB_SPIN_CAP) { atomicAdd(&(bar)[XB_TMO], 1u); break; } } } } while (0)

struct XcdBarrier {
    unsigned* bar; unsigned x;
    volatile LAS unsigned* st;
};

__device__ __forceinline__ XcdBarrier xcd_barrier_post(unsigned* bar, volatile LAS unsigned* st) {
    XcdBarrier b; b.bar = bar; b.x = xb_xcc_id(); b.st = st;
    if (threadIdx.x == 0) (void)xb_add(&bar[XB_XCNT(b.x)], 1u);
    return b;
}
__device__ __forceinline__ void xcd_barrier_complete(unsigned* bar, unsigned x, unsigned& nloc, unsigned& nx) {
    const unsigned G = gridDim.x * gridDim.y * gridDim.z;
    unsigned sum, cnt, mine, sp = 0u;
    for (;;) {
        sum = 0u; cnt = 0u; mine = 0u;
#pragma unroll
        for (unsigned j = 0; j < 16; ++j) { const unsigned c = xb_ld(&bar[XB_XCNT(j)]); sum += c; cnt += (c > 0u) ? 1u : 0u; mine = (j == x) ? c : mine; }
        if (sum == G) break;
        __builtin_amdgcn_s_sleep(1);
        if ((++sp & 255u) == 0u) { if (xb_ld(&bar[XB_TMO])) break; if (sp > XB_SPIN_CAP) { atomicAdd(&bar[XB_TMO], 1u); break; } }
    }
    nloc = mine > 0u ? mine : 1u; nx = cnt > 0u ? cnt : 1u;
}

__device__ __forceinline__ void xcd_barrier(const XcdBarrier& b) {
    asm volatile("s_waitcnt vmcnt(0)" ::: "memory");
    __syncthreads();
    if (threadIdx.x == 0) {
        unsigned* bar = b.bar;
        __builtin_amdgcn_s_waitcnt(0);
        unsigned nloc = b.st[0], nx = b.st[1];
        if (nloc == 0u) { xcd_barrier_complete(bar, b.x, nloc, nx); b.st[0] = nloc; b.st[1] = nx; }
        const unsigned old = xb_add(&bar[XB_XSUB(b.x)], 1u);
        const unsigned gen = old / nloc;
        if (old + 1u == (gen + 1u) * nloc) {
            __builtin_amdgcn_fence(__ATOMIC_RELEASE, "agent");
            asm volatile("s_waitcnt vmcnt(0)" ::: "memory");
            const unsigned og = xb_add(&bar[XB_TOP], 1u);
            const unsigned tg = og / nx;
            if (og + 1u == (tg + 1u) * nx) xb_add(&bar[XB_TOPGEN], 1u);
            else XB_SPIN(xb_ld(&bar[XB_TOPGEN]) == tg, bar);
            __builtin_amdgcn_fence(__ATOMIC_ACQUIRE, "agent");
            xb_add(&bar[XB_XGEN(b.x)], 1u);
            asm volatile("s_waitcnt vmcnt(0)" ::: "memory");
        } else {
            XB_SPIN(xb_ld(&bar[XB_XGEN(b.x)]) == gen, bar);
            __builtin_amdgcn_fence(__ATOMIC_ACQUIRE, "agent");
            asm volatile("s_waitcnt vmcnt(0)" ::: "memory");
        }
    }
    __syncthreads();
}

#ifndef FULL_STAGE
#define FULL_STAGE 0
#endif
namespace fa {
constexpr int D = 128, NW = 8, QBLK = 32, KVBLK = 64, QB = NW * QBLK;
constexpr int SHM_V = KVBLK * D * 2, SHM_K = KVBLK * D * 2;
constexpr int OFF_WS = 2 * SHM_V + 2 * SHM_K, OFF_BIAS = OFF_WS + NW * 64 * 4, OFF_RED = OFF_BIAS + 4224 * 4, OFF_OST = OFF_RED + 256, OFF_QP = OFF_OST + NW * (FULL_STAGE ? 8192 : 4096), QP = FULL_STAGE ? 0 : 4, LDS_BYTES = OFF_QP + QP * NW * 1024;
constexpr float SCALE = 0.08838834764831845f, INV_SCALE = 11.313708498984761f, THR = 8.f;
constexpr int RS = 1024;
constexpr int OS = 2048;
template <class A, class Bt> struct same_t { static constexpr bool v = false; };
template <class A> struct same_t<A, A> { static constexpr bool v = true; };
#define KSWZ(row, colB) ((row) * 256 + ((colB) ^ (((row) & 7) << 4)))
#define SBAR() __builtin_amdgcn_sched_barrier(0)
__device__ __forceinline__ int v_st(int k, int c) { const int kk = (k & ~0xC) | ((k & 4) << 1) | ((k & 8) >> 1); return ((kk >> 3) * 4 + (c >> 5)) * 512 + ((kk & 7) * 32 + (c & 31)) * 2; }
__device__ __forceinline__ int v_rd_base(int lane) { return ((lane & 3) << 3) | (((lane >> 2) & 3) << 6) | (((lane >> 4) & 1) << 5) | (((lane >> 5) & 1) << 8); }
constexpr int v_rd_off(int d0, int ks, int half) { return d0 * 512 + ks * 4096 + half * 2048; }
__device__ __forceinline__ int crow(int r, int hi) { return (r & 3) + 8 * (r >> 2) + 4 * hi; }
__device__ __forceinline__ bf16x8 pack8(f32x4 a, f32x4 b) { u32x4 w = {cvtpk(a[0], a[1]), cvtpk(a[2], a[3]), cvtpk(b[0], b[1]), cvtpk(b[2], b[3])}; return *reinterpret_cast<bf16x8*>(&w); }
__device__ __forceinline__ void mask_tile(f32x16& p0, f32x16& p1, int dq) {
    const float NEG = -__builtin_inff();
#pragma unroll
    for (int r = 0; r < 16; ++r) { const int c = (r & 3) + 8 * (r >> 2); if (dq - c < 0) p0[r] = NEG; if (dq - c - 32 < 0) p1[r] = NEG; }
}
__device__ __forceinline__ void partialSM(f32x16& p0, f32x16& p1, float& m_reg, float& mn, float& alpha) {
    float pmax = p0[0];
#pragma unroll
    for (int r = 1; r < 16; ++r) pmax = fmaxf(pmax, p0[r]);
#pragma unroll
    for (int r = 0; r < 16; ++r) pmax = fmaxf(pmax, p1[r]);
    { auto rr = __builtin_amdgcn_permlane32_swap(__float_as_uint(pmax), __float_as_uint(pmax), false, false); pmax = fmaxf(__uint_as_float(rr[0]), __uint_as_float(rr[1])); }
    constexpr float C2 = 1.4426950408889634f * SCALE;
    if (__builtin_expect(__all((pmax - m_reg) * SCALE <= THR), 1)) { mn = m_reg; alpha = 1.f; }
    else { mn = fmaxf(m_reg, pmax); alpha = __builtin_amdgcn_exp2f((m_reg - mn) * C2); m_reg = mn; }
    const float mnL = -mn * C2;
#pragma unroll
    for (int r = 0; r < 16; ++r) p0[r] = fmaf(p0[r], C2, mnL);
#pragma unroll
    for (int r = 0; r < 16; ++r) p1[r] = fmaf(p1[r], C2, mnL);
#pragma unroll
    for (int r = 0; r < 16; ++r) p0[r] = __builtin_amdgcn_exp2f(p0[r]);
}
__device__ __forceinline__ void finishSM(f32x16& p0, f32x16& p1, float alpha, float& l_reg, bf16x8& pa0, bf16x8& pa1, bf16x8& pa2, bf16x8& pa3) {
#pragma unroll
    for (int r = 0; r < 16; ++r) p1[r] = __builtin_amdgcn_exp2f(p1[r]);
    float ps = 0;
#pragma unroll
    for (int r = 0; r < 16; ++r) ps += p0[r];
#pragma unroll
    for (int r = 0; r < 16; ++r) ps += p1[r];
    { auto rr = __builtin_amdgcn_permlane32_swap(__float_as_uint(ps), __float_as_uint(ps), false, false); ps = __uint_as_float(rr[0]) + __uint_as_float(rr[1]); }
    l_reg = l_reg * alpha + ps;
#define PK4(P, B_, OUT) do { unsigned a0 = cvtpk(P[B_+0], P[B_+1]), a1 = cvtpk(P[B_+2], P[B_+3]);                          \
        unsigned b0 = cvtpk(P[B_+4], P[B_+5]), b1 = cvtpk(P[B_+6], P[B_+7]);                                             \
        auto r0 = __builtin_amdgcn_permlane32_swap(a0, b0, false, false); auto r1 = __builtin_amdgcn_permlane32_swap(a1, b1, false, false); \
        u32x4 w = {r0[0], r1[0], r0[1], r1[1]}; OUT = *reinterpret_cast<bf16x8*>(&w); } while (0)
    PK4(p0, 0, pa0); PK4(p0, 8, pa1); PK4(p1, 0, pa2); PK4(p1, 8, pa3);
#undef PK4
}
template <int KB, int QPK = QP>
__device__ __forceinline__ void qkt(f32x16& p0, f32x16& p1, const char* K_lds, const float* cb, int r32, int hi, const bf16x8* qr, const char* qp) {
    const f32x4* c4 = (const f32x4*)(cb + 4 * hi);
#pragma unroll
    for (int g = 0; g < 4; ++g) { const f32x4 a = c4[2 * g], b = c4[2 * g + 8];
        p0[4 * g] = a[0]; p0[4 * g + 1] = a[1]; p0[4 * g + 2] = a[2]; p0[4 * g + 3] = a[3];
        p1[4 * g] = b[0]; p1[4 * g + 1] = b[1]; p1[4 * g + 2] = b[2]; p1[4 * g + 3] = b[3]; }
    const char* kb[4];
#pragma unroll
    for (int dd = 0; dd < 4; ++dd) kb[dd] = K_lds + KB * SHM_K + KSWZ(r32, (dd * 16 + hi * 8) * 2);
#pragma unroll
    for (int d0 = 0; d0 < 8; ++d0) { const char* a = kb[d0 & 3] + (d0 >> 2) * 128;
        bf16x8 b0 = *reinterpret_cast<const bf16x8*>(a);
        bf16x8 b1 = *reinterpret_cast<const bf16x8*>(a + 32 * 256);
#ifdef T_NOQPREAD
        const bf16x8 q = qr[d0];
#else
        const bf16x8 q = d0 < 8 - QPK ? qr[d0] : *reinterpret_cast<const bf16x8*>(qp + (d0 - (8 - QPK)) * (NW * 1024));
#endif
        p0 = __builtin_amdgcn_mfma_f32_32x32x16_bf16(b0, q, p0, 0, 0, 0);
        p1 = __builtin_amdgcn_mfma_f32_32x32x16_bf16(b1, q, p1, 0, 0, 0); }
}
template <int VB>
__device__ __forceinline__ void pv_tile(f32x16* o, int vb0, bf16x8 pa0, bf16x8 pa1, bf16x8 pa2, bf16x8 pa3) {
#define TRRD(dst, off) asm volatile("ds_read_b64_tr_b16 %0, %1 offset:%2" : "=&v"(dst) : "v"(vb0), "i"(off) : "memory")
#define PV_D0(d0) do { s16x4 l0, l1, l2, l3, h0, h1, h2, h3; constexpr int b_ = VB * SHM_V + v_rd_off(d0, 0, 0); \
        TRRD(l0, b_); TRRD(h0, b_ + 2048); TRRD(l1, b_ + 4096); TRRD(h1, b_ + 6144); TRRD(l2, b_ + 8192); TRRD(h2, b_ + 10240); TRRD(l3, b_ + 12288); TRRD(h3, b_ + 14336); \
        asm volatile("s_waitcnt lgkmcnt(0)" ::: "memory"); SBAR();   \
        o[d0] = __builtin_amdgcn_mfma_f32_32x32x16_bf16(pa0, (bf16x8){l0[0], l0[1], l0[2], l0[3], h0[0], h0[1], h0[2], h0[3]}, o[d0], 0, 0, 0);   \
        o[d0] = __builtin_amdgcn_mfma_f32_32x32x16_bf16(pa1, (bf16x8){l1[0], l1[1], l1[2], l1[3], h1[0], h1[1], h1[2], h1[3]}, o[d0], 0, 0, 0);   \
        o[d0] = __builtin_amdgcn_mfma_f32_32x32x16_bf16(pa2, (bf16x8){l2[0], l2[1], l2[2], l2[3], h2[0], h2[1], h2[2], h2[3]}, o[d0], 0, 0, 0);   \
        o[d0] = __builtin_amdgcn_mfma_f32_32x32x16_bf16(pa3, (bf16x8){l3[0], l3[1], l3[2], l3[3], h3[0], h3[1], h3[2], h3[3]}, o[d0], 0, 0, 0); } while (0)
    PV_D0(0); PV_D0(1); PV_D0(2); PV_D0(3);
#undef PV_D0
#undef TRRD
}
template <class TKV> struct BlockRef { const bf16_t* Q; const TKV* K; const TKV* V; const TKV* K2; const TKV* V2; int nk1; bf16_t* O; const bf16_t* G; int P0; int live; int jlo, jhi; float* po; float* pml; };
struct Seam { bf16x8 qr[8]; bf16x8 st_v0, st_v1, st_k0, st_k1; f32x4 sf0, sf1, sf2, sf3; };
#define KPTR(ref, k0) ((k0) < (ref).nk1 ? (ref).K + (size_t)(k0) * RS : (ref).K2 + (size_t)((k0) - (ref).nk1) * RS)
#define VPTR(ref, k0) ((k0) < (ref).nk1 ? (ref).V + (size_t)(k0) * RS : (ref).V2 + (size_t)((k0) - (ref).nk1) * RS)
#define ROWP(p, rr) ((p) + (size_t)(rr) * RS + sc)
#define VMW() asm volatile("s_waitcnt vmcnt(0)" ::: "memory")
#define VMWN(n) asm volatile("s_waitcnt vmcnt(%0)" :: "i"(n) : "memory")
#define SLOAD_H(ref, k0) do { const TKV* kp_ = KPTR(ref, k0); const TKV* vp_ = VPTR(ref, k0);                                     \
        S.st_v0 = *(const bf16x8*)ROWP((const bf16_t*)vp_, sr); S.st_v1 = *(const bf16x8*)ROWP((const bf16_t*)vp_, 32 + sr);     \
        S.st_k0 = *(const bf16x8*)ROWP((const bf16_t*)kp_, sr); S.st_k1 = *(const bf16x8*)ROWP((const bf16_t*)kp_, 32 + sr); } while (0)
#define SWRITE_HK(bf) do { *(bf16x8*)(K_lds + (bf) * SHM_K + kws) = S.st_k0; *(bf16x8*)(K_lds + (bf) * SHM_K + kws + 32 * 256) = S.st_k1; } while (0)
#define SWRITE_HV(bf) do { *(bf16x8*)(V_lds + (bf) * SHM_V + vst0) = S.st_v0; *(bf16x8*)(V_lds + (bf) * SHM_V + vst1) = S.st_v1; } while (0)
#define SWRITE_H(bf) do { SWRITE_HV(bf); SWRITE_HK(bf); } while (0)
#define SLOAD_F(p_) do { const float* q_ = (const float*)(p_); S.sf0 = *(const f32x4*)ROWP(q_, sr); S.sf1 = *(const f32x4*)(ROWP(q_, sr) + 4);                \
                         S.sf2 = *(const f32x4*)ROWP(q_, 32 + sr); S.sf3 = *(const f32x4*)(ROWP(q_, 32 + sr) + 4); } while (0)
#define SWRITE_KF(bf) do { *(bf16x8*)(K_lds + (bf) * SHM_K + kws) = pack8(S.sf0, S.sf1); *(bf16x8*)(K_lds + (bf) * SHM_K + kws + 32 * 256) = pack8(S.sf2, S.sf3); } while (0)
#define SWRITE_VF(bf) do { *(bf16x8*)(V_lds + (bf) * SHM_V + vst0) = pack8(S.sf0, S.sf1); *(bf16x8*)(V_lds + (bf) * SHM_V + vst1) = pack8(S.sf2, S.sf3); } while (0)
template <class TKV>
__device__ __forceinline__ void attn_prime(const BlockRef<TKV>& cur, char* lds, Seam& S) {
    constexpr bool F32 = same_t<TKV, float>::v;
    const int tid = opaque_tid(), wid = __builtin_amdgcn_readfirstlane(tid >> 6), lane = tid & 63, r32 = lane & 31, hi = lane >> 5;
    const int sr = tid >> 4, sc = (tid & 15) * 8, kws = KSWZ(sr, sc * 2); char* K_lds = lds + 2 * SHM_V;
#pragma unroll
    for (int d0 = 0; d0 < 8; ++d0) S.qr[d0] = *(const bf16x8*)(cur.Q + (size_t)(wid * QBLK + r32) * RS + d0 * 16 + hi * 8);
    const int k0_ = cur.jlo * KVBLK;
    if constexpr (F32) { SLOAD_F(KPTR(cur, k0_)); VMW(); SWRITE_KF(0); SBAR(); SLOAD_F(VPTR(cur, k0_)); }
    else { SLOAD_H(cur, k0_); VMW(); SWRITE_HK(0); }
    __syncthreads();
}
template <class TKV, bool SKIP>
__device__ __forceinline__ void attn_block(const BlockRef<TKV>& cur, const BlockRef<TKV>& nxt, char* lds, Seam& S) {
    constexpr bool F32 = same_t<TKV, float>::v;
    const int tid = opaque_tid(), wid = __builtin_amdgcn_readfirstlane(tid >> 6), lane = tid & 63, r32 = lane & 31, hi = lane >> 5;
    const int j_lo = cur.jlo, NT = cur.jhi - cur.jlo;
    const bool act = !SKIP || (wid * QBLK < cur.live);
    const int kn0 = nxt.jlo * KVBLK;
    const int qlo = cur.P0 + wid * QBLK, qm = qlo + r32 - 4 * hi;
    char* V_lds = lds; char* K_lds = lds + 2 * SHM_V;
    float* ws = (float*)(lds + OFF_WS) + wid * 64; float* li_l = ws, * al_l = ws + 32;
    const float* cbias = (const float*)(lds + OFF_BIAS);
    float m_reg = -1e30f, l_reg = 0; f32x16 o[4] = {};
    const int sr = tid >> 4, sc = (tid & 15) * 8, vst0 = v_st(sr, sc), vst1 = v_st(32 + sr, sc), kws = KSWZ(sr, sc * 2);
    const int vb0 = (int)(uintptr_t)V_lds + v_rd_base(lane);
    char* qp = lds + OFF_QP + tid * 16;
#pragma unroll
    for (int j_ = 0; j_ < QP; ++j_) *reinterpret_cast<bf16x8*>(qp + j_ * (NW * 1024)) = S.qr[8 - QP + j_];
#define RESC(a) do { if (__any((a) < 1.f)) { if (hi == 0) al_l[r32] = (a); asm volatile("s_waitcnt lgkmcnt(0)" ::: "memory");              \
                     for (int d_ = 0; d_ < 4; ++d_) for (int r = 0; r < 16; ++r) o[d_][r] *= al_l[crow(r, hi)]; } } while (0)
#define KBASE(t) ((j_lo + (t)) * KVBLK)
#define MASKT(P0_, P1_, t) do { const int kb_ = KBASE(t); if (kb_ + KVBLK - 1 > qlo) mask_tile(P0_, P1_, qm - kb_); } while (0)
    constexpr int NQL = 8;
#define SEAM_K0() do { VMWN(NQL); if constexpr (F32) { SWRITE_KF(0); SBAR(); SLOAD_F(VPTR(nxt, kn0)); } else { SWRITE_HK(0); } SBAR(); } while (0)
    f32x16 pA0, pA1, pB0, pB1; float mnA, mnB, alA, alB; bf16x8 pa0, pa1, pa2, pa3;
    if constexpr (F32) { VMW(); SWRITE_VF(0); SBAR(); } else { SWRITE_HV(0); SBAR(); }
    if (NT > 1) { if constexpr (F32) SLOAD_F(KPTR(cur, KBASE(1))); else SLOAD_H(cur, KBASE(1)); }
    SBAR(); if (act) qkt<0>(pA0, pA1, K_lds, cbias + KBASE(0), r32, hi, S.qr, qp);
    if constexpr (F32) { if (NT > 1) { VMW(); SWRITE_KF(1); SBAR(); SLOAD_F(VPTR(cur, KBASE(1))); } }
    if (act) { MASKT(pA0, pA1, 0); partialSM(pA0, pA1, m_reg, mnA, alA); }
    if (NT > 1) { VMW(); if constexpr (F32) { SWRITE_VF(1); SBAR(); if (NT > 2) SLOAD_F(KPTR(cur, KBASE(2))); } else SWRITE_H(1); }
    __syncthreads();
#define HALF_STEP(PX0, PX1, mnX, alX, PY0, PY1, alY, t, KB, VB, SB) do {                                                      \
        SBAR(); if (act) { qkt<KB>(PX0, PX1, K_lds, cbias + KBASE(t), r32, hi, S.qr, qp);                                         \
        finishSM(PY0, PY1, alY, l_reg, pa0, pa1, pa2, pa3); } SBAR();                                                         \
        if ((t) + 1 < NT) { if constexpr (F32) { VMW(); SWRITE_KF(SB); SBAR(); SLOAD_F(VPTR(cur, KBASE((t) + 1))); }          \
                            else { SLOAD_H(cur, KBASE((t) + 1)); } SBAR(); }                                                  \
        if (act) { pv_tile<VB>(o, vb0, pa0, pa1, pa2, pa3); MASKT(PX0, PX1, (t)); partialSM(PX0, PX1, m_reg, mnX, alX); }     \
        __syncthreads();                                                                                                      \
        if ((t) + 1 < NT) { VMW(); if constexpr (F32) { SWRITE_VF(SB); SBAR(); if ((t) + 2 < NT) SLOAD_F(KPTR(cur, KBASE((t) + 2))); } \
                            else { SWRITE_H(SB); } }                                                                          \
        if (act) RESC(alX); __syncthreads(); } while (0)
    for (int t = 1; t + 1 < NT; t += 2) {
        HALF_STEP(pB0, pB1, mnB, alB, pA0, pA1, alA, t, 1, 0, 0);
        HALF_STEP(pA0, pA1, mnA, alA, pB0, pB1, alB, t + 1, 0, 1, 1);
    }
    const bool even = (NT & 1) == 0;
    if (even) { SBAR(); if (act) qkt<1>(pB0, pB1, K_lds, cbias + KBASE(NT - 1), r32, hi, S.qr, qp); SBAR(); }
    if constexpr (F32) { SLOAD_F(KPTR(nxt, kn0)); SBAR(); } else { SLOAD_H(nxt, kn0); SBAR(); }
#pragma unroll
    for (int d0 = 0; d0 < 8; ++d0) S.qr[d0] = *(const bf16x8*)(nxt.Q + (size_t)(wid * QBLK + r32) * RS + d0 * 16 + hi * 8);
    SBAR();
    if (act) { finishSM(pA0, pA1, alA, l_reg, pa0, pa1, pa2, pa3); SBAR();
        pv_tile<0>(o, vb0, pa0, pa1, pa2, pa3); }
    if (even) { if (act) { MASKT(pB0, pB1, NT - 1); partialSM(pB0, pB1, m_reg, mnB, alB); } __syncthreads(); if (act) { RESC(alB);
        finishSM(pB0, pB1, alB, l_reg, pa0, pa1, pa2, pa3); SBAR(); pv_tile<1>(o, vb0, pa0, pa1, pa2, pa3); } }
    SBAR(); SEAM_K0();
    if (cur.po != nullptr) {
        if (wid * QBLK < cur.live) {
            int e_ = lane; asm volatile("" : "+v"(e_));
            const int er32 = e_ & 31, ehi = e_ >> 5;
            if (ehi == 0) { float* pm = cur.pml + (size_t)(wid * QBLK + er32) * 2; pm[0] = m_reg; pm[1] = l_reg; }
            float* pp = cur.po + (size_t)(wid * QBLK + 4 * ehi) * D + er32;
#pragma unroll
            for (int r = 0; r < 16; ++r) { const int oc = (r & 3) + 8 * (r >> 2);
#pragma unroll
                for (int d0 = 0; d0 < 4; ++d0) pp[oc * D + d0 * 32] = o[d0][r]; }
        }
    } else {
#if FULL_STAGE
    if (hi == 0) li_l[r32] = l_reg; asm volatile("s_waitcnt lgkmcnt(0)" ::: "memory");
    if (wid * QBLK < cur.live) {
        int e_ = lane; asm volatile("" : "+v"(e_));
        const int erow = e_ >> 4, ech = (e_ & 15) * 8, er32 = e_ & 31, ehi = e_ >> 5;
        bf16_t* stg = (bf16_t*)(lds + OFF_OST) + wid * 4096;
        const bf16_t* gp = cur.G + (size_t)(wid * QBLK + erow) * RS + ech; bf16_t* op = cur.O + (size_t)(wid * QBLK + erow) * OS + ech;
        bf16_t* sp0 = stg + erow * 128 + ech;
#pragma unroll
        for (int i = 0; i < 8; ++i) { *(u32x4*)(sp0 + i * 512) = *(const u32x4*)gp; gp += 4 * RS; }
        asm volatile("s_waitcnt lgkmcnt(0)" ::: "memory");
        bf16_t* sq = stg + ehi * 512 + er32; const float* lq = li_l + 4 * ehi;
#pragma unroll
        for (int r = 0; r < 16; ++r) { const int oc = (r & 3) + 8 * (r >> 2); const float rl = __builtin_amdgcn_rcpf(lq[oc]);
#pragma unroll
            for (int d0 = 0; d0 < 4; ++d0) { bf16_t* sp = sq + oc * 128 + d0 * 32; const float g = __uint_as_float((unsigned)(*sp) << 16);
                *sp = (bf16_t)(cvtpk(o[d0][r] * rl * g, 0.f) & 0xffffu); } }
        asm volatile("s_waitcnt lgkmcnt(0)" ::: "memory");
#pragma unroll
        for (int i = 0; i < 8; ++i) { *(u32x4*)op = *(const u32x4*)(sp0 + i * 512); op += 4 * OS; }
#else
    if (hi == 0) li_l[r32] = l_reg; asm volatile("s_waitcnt lgkmcnt(0)" ::: "memory");
    if (wid * QBLK < cur.live) {
        int e_ = lane; asm volatile("" : "+v"(e_));
        const int erow = e_ >> 3, ech = (e_ & 7) * 8, er32 = e_ & 31, ehi = e_ >> 5;
        bf16_t* stg = (bf16_t*)(lds + OFF_OST) + wid * 2048;
        bf16_t* sp0 = stg + erow * 64 + ech; bf16_t* sq = stg + ehi * 256 + er32; const float* lq = li_l + 4 * ehi;
        float rl[16];
#pragma unroll
        for (int r = 0; r < 16; ++r) rl[r] = __builtin_amdgcn_rcpf(lq[(r & 3) + 8 * (r >> 2)]);
#pragma unroll
        for (int hc = 0; hc < 2; ++hc) {
            const bf16_t* gp = cur.G + (size_t)(wid * QBLK + erow) * RS + hc * 64 + ech; bf16_t* op = cur.O + (size_t)(wid * QBLK + erow) * OS + hc * 64 + ech;
#pragma unroll
            for (int i = 0; i < 4; ++i) { *(u32x4*)(sp0 + i * 512) = *(const u32x4*)gp; gp += 8 * RS; }
            asm volatile("s_waitcnt lgkmcnt(0)" ::: "memory");
#pragma unroll
            for (int r = 0; r < 16; ++r) { const int oc = (r & 3) + 8 * (r >> 2);
#pragma unroll
                for (int dd = 0; dd < 2; ++dd) { bf16_t* sp = sq + oc * 64 + dd * 32; const float g = __uint_as_float((unsigned)(*sp) << 16);
                    *sp = (bf16_t)(cvtpk(o[2 * hc + dd][r] * rl[r] * g, 0.f) & 0xffffu); } }
            asm volatile("s_waitcnt lgkmcnt(0)" ::: "memory");
#pragma unroll
            for (int i = 0; i < 4; ++i) { *(u32x4*)op = *(const u32x4*)(sp0 + i * 512); op += 8 * OS; }
            asm volatile("s_waitcnt lgkmcnt(0)" ::: "memory");
        }
#endif
    }
    }
    __syncthreads();
#undef RESC
#undef KBASE
#undef MASKT
#undef SEAM_K0
#undef HALF_STEP
}

__device__ __forceinline__ void sample_item(const BlockRef<float>& cur, char* lds) {
    const int tid = opaque_tid(), wid = __builtin_amdgcn_readfirstlane(tid >> 6), lane = tid & 63, r32 = lane & 31, hi = lane >> 5;
    const int j_lo = cur.jlo, NT = cur.jhi - cur.jlo;
    const bool comp = wid < 2, ldr = wid >= 4;
    const int qlo = cur.P0 + wid * QBLK, qm = qlo + r32 - 4 * hi;
    char* V_lds = lds; char* K_lds = lds + 2 * SHM_V;
    float* ws = (float*)(lds + OFF_WS) + wid * 64; float* al_l = ws + 32;
    const float* cbias = (const float*)(lds + OFF_BIAS);
    const int vb0 = (int)(uintptr_t)V_lds + v_rd_base(lane);
    const int lt = tid & 255, lsr = lt >> 4, sc = (lt & 15) * 8, kws = KSWZ(lsr, sc * 2), vst0 = v_st(lsr, sc);
#define KBASE(t) ((j_lo + (t)) * KVBLK)
#define LLOAD(set, t) do { const float* kp_ = (const float*)KPTR(cur, KBASE(t)) + (size_t)lsr * RS + sc; const float* vp_ = (const float*)VPTR(cur, KBASE(t)) + (size_t)lsr * RS + sc; \
        _Pragma("unroll") for (int i_ = 0; i_ < 4; ++i_) { kr[set][2 * i_] = *(const f32x4*)(kp_ + (size_t)i_ * 16 * RS); kr[set][2 * i_ + 1] = *(const f32x4*)(kp_ + (size_t)i_ * 16 * RS + 4); } \
        _Pragma("unroll") for (int i_ = 0; i_ < 4; ++i_) { vr[set][2 * i_] = *(const f32x4*)(vp_ + (size_t)i_ * 16 * RS); vr[set][2 * i_ + 1] = *(const f32x4*)(vp_ + (size_t)i_ * 16 * RS + 4); } } while (0)
#define LWRITE_K(set, buf) do { _Pragma("unroll") for (int i_ = 0; i_ < 4; ++i_) *(bf16x8*)(K_lds + (buf) * SHM_K + kws + i_ * 4096) = pack8(kr[set][2 * i_], kr[set][2 * i_ + 1]); } while (0)
#define LWRITE_V(set, buf) do { _Pragma("unroll") for (int i_ = 0; i_ < 4; ++i_) *(bf16x8*)(V_lds + (buf) * SHM_V + vst0 + i_ * 4096) = pack8(vr[set][2 * i_], vr[set][2 * i_ + 1]); } while (0)
#define RESC(a) do { if (__any((a) < 1.f)) { if (hi == 0) al_l[r32] = (a); asm volatile("s_waitcnt lgkmcnt(0)" ::: "memory");              \
                     for (int d_ = 0; d_ < 4; ++d_) for (int r = 0; r < 16; ++r) o[d_][r] *= al_l[crow(r, hi)]; } } while (0)
#define MASKT(P0_, P1_, t) do { const int kb_ = KBASE(t); if (kb_ + KVBLK - 1 > qlo) mask_tile(P0_, P1_, qm - kb_); } while (0)
#define BAR2() do { __syncthreads(); __syncthreads(); } while (0)
    if (ldr) {
        f32x4 kr[2][8], vr[2][8];
        LLOAD(0, 0); if (NT > 1) LLOAD(1, 1); LWRITE_K(0, 0); LWRITE_V(0, 0); if (NT > 2) LLOAD(0, 2);
        __syncthreads();
#define LSTEP(t, KB) do { if ((t) + 1 < NT) LWRITE_K(1 - KB, 1 - KB); __syncthreads(); if ((t) + 1 < NT) LWRITE_V(1 - KB, 1 - KB); if ((t) + 3 < NT) LLOAD(1 - KB, (t) + 3); __syncthreads(); } while (0)
        LSTEP(0, 0);
        for (int t = 1; t + 1 < NT; t += 2) { LSTEP(t, 1); LSTEP(t + 1, 0); }
        if ((NT & 1) == 0) LSTEP(NT - 1, 1);
#undef LSTEP
    } else if (comp) {
        float m_reg = -1e30f, l_reg = 0; f32x16 o[4] = {};
        f32x16 pA0, pA1, pB0, pB1; float mnA, mnB, alA, alB; bf16x8 pa0, pa1, pa2, pa3; bf16x8 qr[8];
#pragma unroll
        for (int d0 = 0; d0 < 8; ++d0) qr[d0] = *(const bf16x8*)(cur.Q + (size_t)(wid * QBLK + r32) * RS + d0 * 16 + hi * 8);
        char* qp = lds + OFF_QP + tid * 16;
#pragma unroll
        for (int j_ = 0; j_ < QP; ++j_) *reinterpret_cast<bf16x8*>(qp + j_ * (NW * 1024)) = qr[8 - QP + j_];
        __syncthreads();
#define CSTEP(PX0, PX1, mnX, alX, PY0, PY1, alY, t, KB, VB, FIRST) do {                                                         \
        SBAR(); qkt<KB>(PX0, PX1, K_lds, cbias + KBASE(t), r32, hi, qr, qp);                                                    \
        if (!(FIRST)) { finishSM(PY0, PY1, alY, l_reg, pa0, pa1, pa2, pa3); SBAR(); pv_tile<VB>(o, vb0, pa0, pa1, pa2, pa3); }  \
        MASKT(PX0, PX1, (t)); partialSM(PX0, PX1, m_reg, mnX, alX);                                                             \
        __syncthreads();                                                                                                        \
        if (!(FIRST)) RESC(alX);                                                                                                \
        __syncthreads(); } while (0)
        CSTEP(pA0, pA1, mnA, alA, pB0, pB1, alB, 0, 0, 1, true);
        for (int t = 1; t + 1 < NT; t += 2) {
            CSTEP(pB0, pB1, mnB, alB, pA0, pA1, alA, t, 1, 0, false);
            CSTEP(pA0, pA1, mnA, alA, pB0, pB1, alB, t + 1, 0, 1, false);
        }
        if ((NT & 1) == 0) { CSTEP(pB0, pB1, mnB, alB, pA0, pA1, alA, NT - 1, 1, 0, false);
            finishSM(pB0, pB1, alB, l_reg, pa0, pa1, pa2, pa3); SBAR(); pv_tile<1>(o, vb0, pa0, pa1, pa2, pa3); }
        else { finishSM(pA0, pA1, alA, l_reg, pa0, pa1, pa2, pa3); SBAR(); pv_tile<0>(o, vb0, pa0, pa1, pa2, pa3); }
#undef CSTEP
        int e_ = lane; asm volatile("" : "+v"(e_));
        const int er32 = e_ & 31, ehi = e_ >> 5;
        if (ehi == 0) { float* pm = cur.pml + (size_t)(wid * QBLK + er32) * 2; pm[0] = m_reg; pm[1] = l_reg; }
        float* pp = cur.po + (size_t)(wid * QBLK + 4 * ehi) * D + er32;
#pragma unroll
        for (int r = 0; r < 16; ++r) { const int oc = (r & 3) + 8 * (r >> 2);
#pragma unroll
            for (int d0 = 0; d0 < 4; ++d0) pp[oc * D + d0 * 32] = o[d0][r]; }
    } else {
        __syncthreads();
        BAR2();
        for (int t = 1; t + 1 < NT; t += 2) { BAR2(); BAR2(); }
        if ((NT & 1) == 0) BAR2();
    }
    __syncthreads();
#undef BAR2
#undef KBASE
#undef LLOAD
#undef LWRITE_K
#undef LWRITE_V
#undef RESC
#undef MASKT
}
#undef ROWP
#undef VMW
#undef VMWN
#undef SLOAD_H
#undef SWRITE_HK
#undef SWRITE_HV
#undef SWRITE_H
#undef SLOAD_F
#undef SWRITE_KF
#undef SWRITE_VF
#undef KPTR
#undef VPTR
#undef SBAR
}

struct Args { const float* in[22]; float* out; unsigned char* ws; int ph_lo, ph_hi; };
enum { I_XP = 0, I_XS, I_CP, I_CS, I_CK, I_CV, I_CLF, I_SCONV, I_WADA, I_BADA, I_NORMG, I_WIN, I_BF, I_QG, I_KG, I_CONVW, I_CONVB, I_LNG, I_LNB, I_WOA, I_WOB, I_WOUT };

__device__ __forceinline__ int srccol(int n) {
    const int tile = n >> 8, r = n & 255;
    if (tile < 12) return n;
    if (tile < 16) return 3080 + (n - 3072);
    if (tile < 24) { const int j = tile - 16; return r < 128 ? 4104 + 128 * j + r : 5128 + 128 * j + (r - 128); }
    if (tile < 28) return 6152 + (n - 6144);
    if (tile < 36) return 7176 + (n - 7168);
    return 9224 + (n - 9216);
}
__device__ __forceinline__ void transpose_item(const float* W, int ldw, int k0, int ns0, bf16_t* WT, int ldt, int nd0, int kd0, LAS float* scr, int lane) {
    float tv[32];
#pragma unroll
    for (int i = 0; i < 32; ++i) tv[i] = W[(size_t)(k0 + 2 * i + (lane >> 5)) * ldw + ns0 + (lane & 31)];
#pragma unroll
    for (int i = 0; i < 32; ++i) scr[(2 * i + (lane >> 5)) * 33 + (lane & 31)] = tv[i];
    asm volatile("s_waitcnt lgkmcnt(0)" ::: "memory");
    const int c = lane & 7;
#pragma unroll
    for (int j = 0; j < 4; ++j) { const int n = (lane >> 3) + 8 * j; const LAS float* s = scr + (8 * c) * 33 + n;
        u32x4 o; o.x = cvtpk(s[0 * 33], s[1 * 33]); o.y = cvtpk(s[2 * 33], s[3 * 33]); o.z = cvtpk(s[4 * 33], s[5 * 33]); o.w = cvtpk(s[6 * 33], s[7 * 33]);
        *(u32x4*)(WT + (size_t)(nd0 + n) * ldt + kd0 + 8 * c) = o; }
    asm volatile("s_waitcnt lgkmcnt(0)" ::: "memory");
}

constexpr int CV_IN = (NIN / 32) * (DM / 64), CV_OA = (DM / 32) * (DA / 64), CV_OUT = (DM / 32) * (DM / 64), CV_PER_L = CV_IN + 2 * CV_OA + CV_OUT;
constexpr int CV_P0_END = CV_IN, CV_W1 = 17430, CV_W2 = 24070, CV_END = DEPTH * CV_PER_L;
__device__ __forceinline__ void convert_range(const Args& A, LAS unsigned char* lds, int lo, int hi, int gw, int ngw) {
    const int tid = opaque_tid(), lane = tid & 63, wave = __builtin_amdgcn_readfirstlane(tid >> 6);
    unsigned char* ws = opaque_p(A.ws);
    LAS float* scr = (LAS float*)(lds + wave * 16384);
    for (int it = lo + gw; it < hi; it += ngw) {
        const int l = it / CV_PER_L; int r = it % CV_PER_L;
        if (r < CV_IN) { const int nb = r % (NIN / 32), kb = r / (NIN / 32);
            transpose_item(A.in[I_WIN] + (size_t)l * DM * DIN, DIN, kb * 64, srccol(nb * 32), (bf16_t*)(ws + WS_WIN) + (size_t)l * NIN * DM, DM, nb * 32, kb * 64, scr, lane); continue; }
        r -= CV_IN;
        if (r < 2 * CV_OA) { const int which = r / CV_OA; r %= CV_OA; const int nb = r % (DM / 32), kb = r / (DM / 32);
            transpose_item(A.in[which ? I_WOB : I_WOA] + (size_t)l * DA * DM, DM, kb * 64, nb * 32, (bf16_t*)(ws + WS_WOAB) + (size_t)l * DM * DM, DM, nb * 32, which * 1024 + kb * 64, scr, lane); continue; }
        r -= 2 * CV_OA;
        { const int nb = r % (DM / 32), kb = r / (DM / 32);
            transpose_item(A.in[I_WOUT] + (size_t)l * DM * DM, DM, kb * 64, nb * 32, (bf16_t*)(ws + WS_WOUT) + (size_t)l * DM * DM, DM, nb * 32, kb * 64, scr, lane); }
    }
}
__device__ __forceinline__ void tail_filler(const Args& A, LAS unsigned char* lds, int nunits, int lo, int hi, int wg_, int G_) {
    const int wg = opaque_s(wg_), G = opaque_s(G_), rem = nunits % G;
    const int busy = 2 * rem <= G ? 2 * rem : rem;
    if (rem == 0 || wg < busy) return;
    const int wave = __builtin_amdgcn_readfirstlane(opaque_tid() >> 6);
    convert_range(A, lds, lo, hi, (wg - busy) * NWAVES + wave, (G - busy) * NWAVES);
}
__device__ __forceinline__ void p0_prologue(const Args& A, LAS unsigned char* lds, int wg_, int G_) {
    const int wg = opaque_s(wg_), G = opaque_s(G_);
    const int tid = opaque_tid(), lane = tid & 63, wave = __builtin_amdgcn_readfirstlane(tid >> 6);
    unsigned char* ws = opaque_p(A.ws);
    {
        LAS float* sc = (LAS float*)lds;
        LAS float* red = (LAS float*)(lds + 81920);
        float* mod = (float*)(ws + WS_MOD);
        for (int u = wg; u < 2 * 96; u += G) {
            const int l = u / 96, cb = u % 96, col = cb * 64 + lane;
            const float* W = A.in[I_WADA] + (size_t)l * DM * 6144;
            float acc[NSEQ];
#pragma unroll
            for (int s = 0; s < NSEQ; ++s) acc[s] = 0.f;
            for (int half = 0; half < 2; ++half) {
                __syncthreads();
                for (int e = tid; e < 1024 * NSEQ; e += NTHR) { const int kk = e / NSEQ, s = e % NSEQ; const int k = half * 1024 + kk;
                    const float c = s < NB ? A.in[I_CP][s * DM + k] : A.in[I_CS][(s - NB) * DM + k];
                    sc[e] = c * fsigmoid(c); }
                __syncthreads();
                const int kb = wave * 128;
#pragma unroll 1
                for (int k0 = 0; k0 < 128; k0 += 32) {
                    float wv[32];
#pragma unroll
                    for (int kk = 0; kk < 32; ++kk) wv[kk] = W[(size_t)(half * 1024 + kb + k0 + kk) * 6144 + col];
#pragma unroll
                    for (int kk = 0; kk < 32; ++kk) {
                        const LAS f32x4* s4 = (const LAS f32x4*)(sc + (kb + k0 + kk) * NSEQ);
#pragma unroll
                        for (int q = 0; q < 5; ++q) { const f32x4 v = s4[q]; acc[4 * q] += wv[kk] * v[0]; acc[4 * q + 1] += wv[kk] * v[1]; acc[4 * q + 2] += wv[kk] * v[2]; acc[4 * q + 3] += wv[kk] * v[3]; }
                    }
                }
            }
#pragma unroll
            for (int s = 0; s < NSEQ; ++s) red[(wave * NSEQ + s) * 64 + lane] = acc[s];
            __syncthreads();
            for (int e = tid; e < NSEQ * 64; e += NTHR) { const int s = e >> 6, c = e & 63; float t = 0.f;
#pragma unroll
                for (int w = 0; w < 8; ++w) t += red[(w * NSEQ + s) * 64 + c];
                mod[((size_t)l * NSEQ + s) * 6144 + cb * 64 + c] = t + A.in[I_BADA][l * 6144 + cb * 64 + c]; }
            __syncthreads();
        }
    }
    const int gw = wg * NWAVES + wave, NGW = G * NWAVES;
    {
        float* FC = (float*)(ws + WS_FC);
        for (int u = gw; u < DEPTH * DB * NH; u += NGW) {
            const int h = u % NH, lb = u / NH; const float* src = A.in[I_CLF] + (size_t)lb * PAST * NH + h; float* dst = FC + (size_t)u * PAST;
            float carry = 0.f;
            for (int j = 0; j < PAST / 64; ++j) {
                float v = src[(size_t)(j * 64 + lane) * NH];
#pragma unroll
                for (int o = 1; o < 64; o <<= 1) { const float t = __shfl_up(v, o); if (lane >= o) v += t; }
                v += carry; dst[j * 64 + lane] = v; carry = __shfl(v, 63);
            }
        }
    }
    {
        float* WF = (float*)(ws + WS_WF);
        for (int e = wg * NTHR + tid; e < DEPTH * NH * DM; e += G * NTHR) { const int k = e % DM, h = (e / DM) % NH, l = e / (DM * NH);
            WF[e] = A.in[I_WIN][((size_t)l * DM + k) * DIN + 3072 + h]; }
    }
    __syncthreads();
    convert_range(A, lds, 0, CV_P0_END, gw, NGW);
}

__device__ __forceinline__ void p1_norm(const Args& A, int l, LAS unsigned char* lds, int wg_, int G_) {
    const int wg = opaque_s(wg_), G = opaque_s(G_);
    const int tid = opaque_tid(), lane = tid & 63, wave = __builtin_amdgcn_readfirstlane(tid >> 6);
    unsigned char* ws = opaque_p(A.ws);
    LAS float* wf = (LAS float*)lds;
    LAS float* gs = (LAS float*)(lds + 65536);
    LAS float* sh = (LAS float*)(lds + 65536 + 8192);
    const float* WF = (const float*)(ws + WS_WF) + (size_t)l * NH * DM;
    const float* mod = (const float*)(ws + WS_MOD) + (size_t)l * NSEQ * 6144;
    bf16_t* H = (bf16_t*)(ws + WS_H);
    for (int e = tid; e < NH * DM / 4; e += NTHR) ((LAS f32x4*)wf)[e] = ((const f32x4*)WF)[e];
    const float* xp = l == 0 ? A.in[I_XP] : A.out + O_YP; const float* xs = l == 0 ? A.in[I_XS] : A.out + O_YS;
    float bfv = 0.f; if (lane < NH) bfv = A.in[I_BF][l * NH + lane];
    for (int u = wg; u < 2 * (MP / 32); u += G) {
        const bool smp = u >= MP / 32; const int row0 = smp ? MP + (u - MP / 32) * 4 : u * 32, s = seq_of_row(row0), nr = smp ? 1 : 4;
        __syncthreads();
        for (int e2 = tid; e2 < DM; e2 += NTHR) { gs[e2] = A.in[I_NORMG][l * DM + e2] * (1.0f + mod[(size_t)s * 6144 + DM + e2]); sh[e2] = mod[(size_t)s * 6144 + e2]; }
        __syncthreads();
        if (smp && wave >= 4) continue;
        const int rbase = smp ? row0 + wave : row0 + wave * 4;
        f32x4 v[8], vn[8];
        { const float* xrow = rbase < MP ? xp + (size_t)rbase * DM : xs + (size_t)(rbase - MP) * DM; const f32x4* xr = (const f32x4*)xrow + lane;
#pragma unroll
          for (int j = 0; j < 8; ++j) v[j] = xr[64 * j]; }
#pragma unroll 1
        for (int rr = 0; rr < nr; ++rr) {
            const int row = rbase + rr;
            if (rr + 1 < nr) { const float* xrow = xp + (size_t)(row + 1) * DM; const f32x4* xr = (const f32x4*)xrow + lane;
#pragma unroll
                for (int j = 0; j < 8; ++j) vn[j] = xr[64 * j]; }
            float ss = 0.f;
#pragma unroll
            for (int j = 0; j < 8; ++j) ss += (v[j][0] * v[j][0] + v[j][1] * v[j][1]) + (v[j][2] * v[j][2] + v[j][3] * v[j][3]);
            const float rstd = __builtin_amdgcn_rsqf(wave_sum(ss) * (1.0f / DM) + EPS);
            u32x2* ho = (u32x2*)(H + (size_t)row * DM) + lane;
#pragma unroll
            for (int j = 0; j < 8; ++j) { const f32x4 g4 = ((const LAS f32x4*)gs)[lane + 64 * j], s4 = ((const LAS f32x4*)sh)[lane + 64 * j];
                v[j] = v[j] * rstd * g4 + s4; u32x2 w; w.x = cvtpk(v[j][0], v[j][1]); w.y = cvtpk(v[j][2], v[j][3]); ho[64 * j] = w; }
            float fl[NH];
#pragma unroll
            for (int h = 0; h < NH; ++h) { float a = 0.f;
#pragma unroll
                for (int j = 0; j < 8; ++j) { const f32x4 w4 = ((const LAS f32x4*)(wf + h * DM))[lane + 64 * j]; a += (v[j][0] * w4[0] + v[j][1] * w4[1]) + (v[j][2] * w4[2] + v[j][3] * w4[3]); }
                fl[h] = wave_sum(a); }
            float mine = 0.f;
#pragma unroll
            for (int h = 0; h < NH; ++h) mine = lane == h ? fl[h] : mine;
            if (lane < NH) { const float z = mine + bfv; const float lf = fminf(z, 0.f) - log1pf(__expf(-fabsf(z)));
                float* o = row < MP ? A.out + O_FP + ((size_t)l * MP + row) * NH : A.out + O_FS + ((size_t)l * MS + (row - MP)) * NH; o[lane] = lf; }
#pragma unroll
            for (int j = 0; j < 8; ++j) v[j] = vn[j];
        }
    }
}

__device__ __forceinline__ void fill_bias_prompt(char* lds, const float* logf  , int nkeys) {
    const int tid = opaque_tid(), lane = tid & 63, wave = tid >> 6;
    float* cb = (float*)(lds + fa::OFF_BIAS); float* red = (float*)(lds + fa::OFF_RED);
    float v[4]; float run = 0.f;
#pragma unroll
    for (int j = 0; j < 4; ++j) { const int k = 4 * tid + j; const float x = k < nkeys ? logf[(size_t)k * NH] : 0.f; run += x; v[j] = run; }
    float incl = run;
#pragma unroll
    for (int o = 1; o < 64; o <<= 1) { const float t = __shfl_up(incl, o); if (lane >= o) incl += t; }
    if (lane == 63) red[wave] = incl;
    __syncthreads();
    float off = incl - run;
    for (int w = 0; w < wave; ++w) off += red[w];
#pragma unroll
    for (int j = 0; j < 4; ++j) { const int k = 4 * tid + j; if (k < nkeys) cb[k] = -(off + v[j]) * fa::INV_SCALE; }
    __syncthreads();
}
__device__ __forceinline__ void fill_bias_sample(char* lds, const float* FCrow, const float* logf_new  ) {
    const int tid = opaque_tid(), lane = tid & 63;
    float* cb = (float*)(lds + fa::OFF_BIAS);
    for (int k = tid; k < PAST; k += NTHR) cb[k] = -FCrow[k] * fa::INV_SCALE;
    if (tid < 64) { float v = logf_new[(size_t)lane * NH];
#pragma unroll
        for (int o = 1; o < 64; o <<= 1) { const float t = __shfl_up(v, o); if (lane >= o) v += t; }
        cb[PAST + lane] = -(FCrow[PAST - 1] + v) * fa::INV_SCALE; }
    __syncthreads();
}
__device__ __forceinline__ void conv_unit(const Args& A, int l, char* lds, int u) {
    const int tid = opaque_tid(), lane = tid & 63, wave = __builtin_amdgcn_readfirstlane(tid >> 6);
    unsigned char* ws = opaque_p(A.ws);
    const bf16_t* U = (const bf16_t*)(ws + WS_U); const bf16_t* GB = (const bf16_t*)(ws + WS_GB); bf16_t* YAB = (bf16_t*)(ws + WS_YAB);
    int s, t0, mrow0; bool prompt = u < 512;
    if (prompt) { s = u >> 7; t0 = (u & 127) * 16; mrow0 = s * SEQ; } else { const int v = u - 512; s = v >> 2; t0 = (v & 3) * 16; mrow0 = MP + s * DS; }
    bf16_t* ut = (bf16_t*)lds;
    float* cv = (float*)(lds + 46 * 2048);
    __syncthreads();
    for (int e = tid; e < 46 * 128; e += NTHR) { const int r = e >> 7, c8 = (e & 127) * 8, t = t0 - 30 + r;
        u32x4 w = {0u, 0u, 0u, 0u};
        if (t >= 0) w = *(const u32x4*)(U + (size_t)(mrow0 + t) * DC + c8);
        else if (!prompt) { const float* sp = A.in[I_SCONV] + (((size_t)l * DB + s) * 30 + (30 + t)) * DC + c8; w = pack8f(*(const f32x4*)sp, *(const f32x4*)(sp + 4)); }
        *(u32x4*)(ut + r * 1024 + c8) = w; }
    float w0[CW], w1[CW];
    const float* cw = A.in[I_CONVW] + (size_t)l * CW * DC + 2 * tid;
#pragma unroll
    for (int j = 0; j < CW; ++j) { const f32x2v w = *(const f32x2v*)(cw + (size_t)j * DC); w0[j] = w[0]; w1[j] = w[1]; }
    const f32x2v cbv = *(const f32x2v*)(A.in[I_CONVB] + l * DC + 2 * tid);
    __syncthreads();
#pragma unroll 1
    for (int sub = 0; sub < 2; ++sub) {
#pragma unroll 1
        for (int tt = 0; tt < 8; ++tt) {
            const int r0 = sub * 8 + tt; float a0 = cbv[0], a1 = cbv[1];
            const unsigned* up = (const unsigned*)(ut + r0 * 1024) + tid;
#pragma unroll
            for (int j = 0; j < CW; ++j) { const unsigned x = up[j * 512]; a0 += w0[j] * bf_lo(x); a1 += w1[j] * bf_hi(x); }
            *(f32x2v*)(cv + tt * 1024 + 2 * tid) = (f32x2v){a0, a1};
        }
        __syncthreads();
        {
            const int t = t0 + sub * 8 + wave; const size_t m = (size_t)mrow0 + t;
            const f32x4* c4 = (const f32x4*)(cv + wave * 1024) + lane;
            f32x4 x[4]; float sum = 0.f;
#pragma unroll
            for (int j = 0; j < 4; ++j) { x[j] = c4[64 * j]; sum += (x[j][0] + x[j][1]) + (x[j][2] + x[j][3]); }
            const float mean = wave_sum(sum) * (1.0f / DC); float sq = 0.f;
#pragma unroll
            for (int j = 0; j < 4; ++j) { x[j] = x[j] - mean; sq += (x[j][0] * x[j][0] + x[j][1] * x[j][1]) + (x[j][2] * x[j][2] + x[j][3] * x[j][3]); }
            const float rstd = __builtin_amdgcn_rsqf(wave_sum(sq) * (1.0f / DC) + EPS);
#pragma unroll
            for (int j = 0; j < 4; ++j) { const int c = 4 * lane + 256 * j;
                const f32x4 g4 = *(const f32x4*)(A.in[I_LNG] + l * DC + c), b4 = *(const f32x4*)(A.in[I_LNB] + l * DC + c);
                const u32x2 gb = *(const u32x2*)(GB + m * DC + c);
                f32x4 y = x[j] * rstd * g4 + b4;
#pragma unroll
                for (int i = 0; i < 4; ++i) y[i] *= fsigmoid(y[i]);
                y[0] *= bf_lo(gb.x); y[1] *= bf_hi(gb.x); y[2] *= bf_lo(gb.y); y[3] *= bf_hi(gb.y);
                u32x2 o; o.x = cvtpk(y[0], y[1]); o.y = cvtpk(y[2], y[3]);
                *(u32x2*)(YAB + m * 2048 + 1024 + c) = o; }
        }
        __syncthreads();
    }
}
__device__ __forceinline__ int q3_grab(unsigned* ctr, LAS unsigned* slot) {
#ifdef Q3_STATIC
    __syncthreads(); const int v_ = (int)slot[1]; __syncthreads(); if (threadIdx.x == 0) slot[1] = v_ + gridDim.x; __syncthreads(); return v_;
#endif
    __syncthreads();
    if (threadIdx.x == 0) slot[0] = __hip_atomic_fetch_add(ctr, 1u, __ATOMIC_RELAXED, __HIP_MEMORY_SCOPE_AGENT);
    __syncthreads();
    return (int)slot[0];
}
constexpr int Q3_PROMPT = NB * NH * 4, Q3_SAMPLE = DB * NH * 2, Q3_CONVCH = 1, Q3_CONV = 576 / Q3_CONVCH, Q3_TOTAL = Q3_PROMPT + Q3_SAMPLE + Q3_CONV;
constexpr int S_SPLIT = 32;
__device__ __forceinline__ void p3_mix(const Args& A, int l, char* lds, LAS unsigned* slot, unsigned* ctr) {
    unsigned char* ws = opaque_p(A.ws);
    const bf16_t* Q = (const bf16_t*)(ws + WS_Q); const bf16_t* Kb = (const bf16_t*)(ws + WS_K); const bf16_t* Vb = (const bf16_t*)(ws + WS_V);
    const bf16_t* GA = (const bf16_t*)(ws + WS_GA); bf16_t* YAB = (bf16_t*)(ws + WS_YAB);
#ifdef Q3_STATIC
    __syncthreads(); if (threadIdx.x == 0) slot[1] = (unsigned)opaque_s((int)blockIdx.x); __syncthreads();
#endif
#ifdef OLD_P3
    const int G_ = gridDim.x, wg_ = blockIdx.x, GP_ = G_ / 2;
    for (int item = (wg_ < GP_ ? wg_ : Q3_PROMPT + 2 * (wg_ - GP_)), k_ = 0; item < Q3_TOTAL; ++k_, item = (wg_ < GP_ ? Q3_PROMPT + Q3_SAMPLE + (wg_ + (k_ - 1) * GP_) : Q3_TOTAL)) {
        __syncthreads();
#else
#ifndef Q3_DUP
#define Q3_DUP 0
#endif
    constexpr int Q3_EXTRA = Q3_DUP == 1 ? Q3_PROMPT : Q3_DUP == 2 ? Q3_SAMPLE : Q3_DUP == 3 ? Q3_CONV : 0;
    for (int item_ = q3_grab(ctr, slot); item_ < Q3_TOTAL + Q3_EXTRA; item_ = q3_grab(ctr, slot)) {
        const int item = item_ < Q3_TOTAL ? item_ : (Q3_DUP == 1 ? item_ - Q3_TOTAL : Q3_DUP == 2 ? Q3_PROMPT + (item_ - Q3_TOTAL) : Q3_PROMPT + Q3_SAMPLE + (item_ - Q3_TOTAL));
#endif
        if (item < Q3_PROMPT) {
            const int bh = item >> 2, x = item & 3, b = bh >> 3, h = bh & 7;
            fill_bias_prompt(lds, A.out + O_FP + ((size_t)l * MP + (size_t)b * SEQ) * NH + h, (8 - x) * 256);
            const size_t base = (size_t)b * SEQ * 1024 + h * 128;
            fa::BlockRef<bf16_t> r0, r1;
            r0.K = Kb + base; r0.V = Vb + base; r0.K2 = r0.K; r0.V2 = r0.V; r0.nk1 = 1 << 30; r0.live = 256; r0.po = nullptr; r0.pml = nullptr; r0.jlo = 0;
            r1 = r0;
            r0.P0 = x * 256; r0.Q = Q + base + (size_t)r0.P0 * 1024; r0.G = GA + base + (size_t)r0.P0 * 1024; r0.O = YAB + ((size_t)b * SEQ + r0.P0) * 2048 + h * 128; r0.jhi = r0.P0 / 64 + 4;
            r1.P0 = (7 - x) * 256; r1.Q = Q + base + (size_t)r1.P0 * 1024; r1.G = GA + base + (size_t)r1.P0 * 1024; r1.O = YAB + ((size_t)b * SEQ + r1.P0) * 2048 + h * 128; r1.jhi = r1.P0 / 64 + 4;
            fa::Seam S;
            fa::attn_prime<bf16_t>(r0, lds, S);
#pragma unroll 1
            for (int pass = 0; pass < 2; ++pass) fa::attn_block<bf16_t, false>(pass ? r1 : r0, r1, lds, S);
        } else if (item < Q3_PROMPT + Q3_SAMPLE) {
            const int it = item - Q3_PROMPT, bh = it >> 1, half = it & 1, b = bh >> 3, h = bh & 7;
            fill_bias_sample(lds, (const float*)(ws + WS_FC) + (((size_t)l * DB + b) * NH + h) * PAST, A.out + O_FS + ((size_t)l * MS + (size_t)b * DS) * NH + h);
            fa::BlockRef<float> r;
            const size_t cbase = (((size_t)l * DB + b) * PAST) * 1024 + h * 128, nbase = ((size_t)l * MS + (size_t)b * DS) * 1024 + h * 128;
            r.K = A.in[I_CK] + cbase; r.V = A.in[I_CV] + cbase; r.K2 = A.out + O_KS + nbase; r.V2 = A.out + O_VS + nbase; r.nk1 = PAST;
            const size_t qb = ((size_t)MP + (size_t)b * DS) * 1024 + h * 128;
            r.Q = Q + qb; r.G = GA + qb; r.O = YAB + ((size_t)MP + (size_t)b * DS) * 2048 + h * 128; r.P0 = PAST; r.live = DS;
#ifdef T_NOSPLIT
            if (half) continue;
            r.jlo = 0; r.jhi = (PAST + DS) / 64; r.po = nullptr; r.pml = nullptr;
#else
            r.jlo = half ? S_SPLIT : 0; r.jhi = half ? (PAST + DS) / 64 : S_SPLIT;
            r.po = (float*)(ws + WS_PO) + ((size_t)bh * 2 + half) * DS * 128; r.pml = (float*)(ws + WS_PML) + ((size_t)bh * 2 + half) * DS * 2;
#endif
            fa::sample_item(r, lds);
        } else {
            const int c0 = (item - Q3_PROMPT - Q3_SAMPLE) * Q3_CONVCH;
#pragma unroll 1
            for (int u = c0; u < c0 + Q3_CONVCH; ++u) conv_unit(A, l, lds, u);
        }
    }
}
__device__ __forceinline__ void p3b_combine(const Args& A, int wg_, int G_) {
#ifdef T_NOSPLIT
    return;
#endif
    const int wg = opaque_s(wg_), G = opaque_s(G_);
    const int tid = opaque_tid(), lane = tid & 63, wave = __builtin_amdgcn_readfirstlane(tid >> 6);
    unsigned char* ws = opaque_p(A.ws);
    const float* PO = (const float*)(ws + WS_PO); const float* PML = (const float*)(ws + WS_PML);
    const bf16_t* GA = (const bf16_t*)(ws + WS_GA); bf16_t* YAB = (bf16_t*)(ws + WS_YAB);
    constexpr float C2 = 1.4426950408889634f * fa::SCALE;
    for (int u = wg * NWAVES + wave; u < DB * NH * DS; u += G * NWAVES) {
        const int bh = u >> 6, row = u & 63, b = bh >> 3, h = bh & 7;
        const float* ml = PML + (size_t)bh * 2 * DS * 2 + row * 2;
        const float m0 = ml[0], l0 = ml[1], m1 = ml[DS * 2], l1 = ml[DS * 2 + 1];
        const float M = fmaxf(m0, m1), w0 = __builtin_amdgcn_exp2f((m0 - M) * C2), w1 = __builtin_amdgcn_exp2f((m1 - M) * C2);
        const float inv = 1.0f / (w0 * l0 + w1 * l1);
        const f32x2v o0 = *(const f32x2v*)(PO + ((size_t)bh * 2 * DS + row) * 128 + 2 * lane), o1 = *(const f32x2v*)(PO + (((size_t)bh * 2 + 1) * DS + row) * 128 + 2 * lane);
        const size_t m = (size_t)MP + (size_t)b * DS + row;
        const unsigned g = *(const unsigned*)(GA + m * 1024 + h * 128 + 2 * lane);
        *(unsigned*)(YAB + m * 2048 + h * 128 + 2 * lane) = cvtpk((w0 * o0[0] + w1 * o1[0]) * inv * bf_lo(g), (w0 * o0[1] + w1 * o1[1]) * inv * bf_hi(g));
    }
}

#ifndef P4_ALIGN
#define P4_ALIGN true
#endif
#ifndef P5_ALIGN
#define P5_ALIGN true
#endif
constexpr int PPL = 6;
constexpr int N_PHASES = 1 + PPL * DEPTH;
__global__ void __launch_bounds__(NTHR, 2) fox_fwd(Args args) {
    extern __shared__ __attribute__((aligned(16))) unsigned char lds[];
    LAS unsigned char* L = (LAS unsigned char*)lds;
    volatile LAS unsigned* MISC = (volatile LAS unsigned*)(L + MISC_OFF);
    const int tid = threadIdx.x;
    const int G = gridDim.x, wg = blockIdx.x;
    if (tid < 32) MISC[tid] = 0u;
    __syncthreads();
    unsigned char* ws = args.ws;
    unsigned* ctl = (unsigned*)(ws + WS_CTL);
#if MK_ONE_LAUNCH
    constexpr int lo = 0, hi = N_PHASES;
#else
    const int lo = args.ph_lo, hi = args.ph_hi;
#endif
    XcdBarrier bar; bar.bar = ctl + CW_BAR; bar.x = 0; bar.st = nullptr;
    if (hi - lo > 1) bar = xcd_barrier_post(ctl + CW_BAR, MISC + 8);
#define IN(k) (lo <= (k) && (k) < hi)
#define SEAM(k) do { if (IN((k) + 1)) xcd_barrier(bar); } while (0)
#ifndef PHM
#define PHM 63
#endif
#ifndef REP_MASK
#define REP_MASK 0
#endif
#define REPS(bit, l) (((REP_MASK >> (bit)) & 1) && (l) == 0 ? 2 : 1)
    if ((PHM & 1) && IN(0)) { for (int rep = 0; rep < REPS(0, 0); ++rep) { p0_prologue(args, L, wg, G); SEAM(0); } }
    for (int l = 0; l < DEPTH; ++l) {
        const int pb = 1 + PPL * l;
        ws = opaque_p(args.ws);
        if ((PHM & 2) && IN(pb + 0)) { for (int rep = 0; rep < REPS(1, l); ++rep) { p1_norm(args, l, L, wg, G); SEAM(pb + 0); } }
        if ((PHM & 4) && IN(pb + 1)) { for (int rep = 0; rep < REPS(2, l); ++rep) {
            pg8::Gemm g{(const bf16_t*)(ws + WS_H), (const bf16_t*)(ws + WS_WIN) + (size_t)l * NIN * DM, MT, NIN, DM};
            pg8::StaticOrder S; S.init(MT, NIN, G, wg);
            EpiIn E{ws, args.out, l, args.in[I_QG] + l * HD, args.in[I_KG] + l * HD, (LAS float*)(L + XS_OFF)};
            pg8::gemm_phase<EpiIn, pg8::StaticOrder, true, true>(L, g, S, E);
            if (l == 0) tail_filler(args, L, (MT / 256) * (NIN / 256), CV_P0_END, CV_W1, wg, G);
            SEAM(pb + 1);
        } }
        for (int rep = 0; rep < REPS(3, l); ++rep) {
        if ((PHM & 8) && IN(pb + 2)) { p3_mix(args, l, (char*)lds, (LAS unsigned*)(MISC + 16), ctl + CW_Q3 + 64 * (2 * l + rep)); SEAM(pb + 2); }
        if ((PHM & 8) && IN(pb + 3)) { p3b_combine(args, wg, G); SEAM(pb + 3); }
        }
        if ((PHM & 16) && IN(pb + 4)) { for (int rep = 0; rep < REPS(4, l); ++rep) {
            pg8::Gemm g{(const bf16_t*)(ws + WS_YAB), (const bf16_t*)(ws + WS_WOAB) + (size_t)l * DM * DM, MT, DM, DM};
            pg8::StaticOrder S; S.init(MT, DM, G, wg);
            EpiMerge E{(const bf16_t*)(ws + WS_SA), (const bf16_t*)(ws + WS_SB), (bf16_t*)(ws + WS_H)};
            pg8::gemm_phase<EpiMerge, pg8::StaticOrder, P4_ALIGN, true>(L, g, S, E);
            if (l == 0) tail_filler(args, L, (MT / 256) * (DM / 256), CV_W1, CV_W2, wg, G);
            SEAM(pb + 4);
        } }
        if ((PHM & 32) && IN(pb + 5)) { for (int rep = 0; rep < REPS(5, l); ++rep) {
            pg8::Gemm g{(const bf16_t*)(ws + WS_H), (const bf16_t*)(ws + WS_WOUT) + (size_t)l * DM * DM, MT, DM, DM};
            pg8::StaticOrder S; S.init(MT, DM, G, wg);
            EpiOut E{l == 0 ? args.in[I_XP] : args.out + O_YP, l == 0 ? args.in[I_XS] : args.out + O_YS, args.out, (const float*)(ws + WS_MOD) + (size_t)l * NSEQ * 6144 + 2 * DM};
            pg8::gemm_phase<EpiOut, pg8::StaticOrder, P5_ALIGN, true>(L, g, S, E);
            if (l == 0) tail_filler(args, L, (MT / 256) * (DM / 256), CV_W2, CV_END, wg, G);
            SEAM(pb + 5);
        } }
    }
#undef IN
#undef SEAM
}

extern "C" void kernel_launch(void* const* d_in, const int* in_sizes, int n_in, void* d_out, int out_size, void* d_ws, size_t ws_size, hipStream_t stream) {
    static int grid = 0;
    if (grid == 0) {
        if (n_in != 22 || out_size != (int)O_END || ws_size < WS_END) { fprintf(stderr, "kernel_launch: unexpected shapes (n_in %d, out %d, ws %zu)\n", n_in, out_size, ws_size); grid = -1; return; }
        int dev = 0, cus = 0, per_cu = 0;
        if (hipGetDevice(&dev) != hipSuccess || hipDeviceGetAttribute(&cus, hipDeviceAttributeMultiprocessorCount, dev) != hipSuccess) { grid = -1; return; }
        if (hipFuncSetAttribute((const void*)fox_fwd, hipFuncAttributeMaxDynamicSharedMemorySize, LDS_BYTES) != hipSuccess) { fprintf(stderr, "kernel_launch: hipFuncSetAttribute failed\n"); grid = -1; return; }
        if (hipOccupancyMaxActiveBlocksPerMultiprocessor(&per_cu, (const void*)fox_fwd, NTHR, LDS_BYTES) != hipSuccess || per_cu < 1) { fprintf(stderr, "kernel_launch: occupancy query says %d\n", per_cu); (void)hipGetLastError(); }
        grid = cus;
    }
    if (grid < 0) return;
    (void)hipMemsetAsync((char*)d_ws + WS_CTL, 0, CTL_ZERO_BYTES, stream);
    Args a{};
    for (int i = 0; i < 22; ++i) a.in[i] = (const float*)d_in[i];
    a.out = (float*)d_out; a.ws = (unsigned char*)d_ws;
#if MK_ONE_LAUNCH
    a.ph_lo = 0; a.ph_hi = N_PHASES;
    hipLaunchKernelGGL(fox_fwd, dim3(grid), dim3(NTHR), LDS_BYTES, stream, a);
#else
    for (int p = 0; p < N_PHASES; ++p) { a.ph_lo = p; a.ph_hi = p + 1; hipLaunchKernelGGL(fox_fwd, dim3(grid), dim3(NTHR), LDS_BYTES, stream, a); }
#endif
}
```
